# Optimizing an MI355X kernel written in HIP

```python
import math, functools
import jax, jax.numpy as jnp
from jax import lax
import numpy as np

D_MODEL = 2048
BATCH = 4
SEQ = 8192
DEPTH = 1
DEC_BATCH = 32
DEC_SEQ = 64
PAST_LEN = 2048

CHUNK = 64
N_META = 16
Q_BLOCK = 128
HEAD_DIM = 128
A_HEADS = 4
A_VDIM = 2 * HEAD_DIM
B_HEADS = 8
ROPE_DIM = HEAD_DIM // 4
ROPE_THETA = 500000.0
D_FF = 5632
EPS = 1e-6
FORGET_BIAS = 2.0
NEG = -1e30
A_Q = A_HEADS * 2 * HEAD_DIM
A_V = A_HEADS * A_VDIM
B_QK = B_HEADS * HEAD_DIM
N_IN = 2 * A_Q + A_V + 3 * B_QK + B_HEADS
SPLITS = (A_Q, 2 * A_Q, 2 * A_Q + A_V, 2 * A_Q + A_V + B_QK,
          2 * A_Q + A_V + 2 * B_QK, 2 * A_Q + A_V + 3 * B_QK)

kernel_name = 'hybrid_diff_fox_macaron_stream'


def _rmsnorm(x, g):
    xf = x.astype(jnp.float32)
    y = xf * lax.rsqrt(jnp.mean(xf * xf, axis=-1, keepdims=True) + EPS)
    return (y * g.astype(jnp.float32)).astype(x.dtype)


def _swiglu(h, w1, w3, w2):
    return (jax.nn.silu(h @ w1) * (h @ w3)) @ w2


def _rope(x, pos):
    half = ROPE_DIM // 2
    inv = jnp.power(ROPE_THETA, -jnp.arange(half, dtype=jnp.float32) * 2.0 / ROPE_DIM)
    ang = pos.astype(jnp.float32)[:, None] * inv[None, :]
    shape = (1, ang.shape[0]) + (1,) * (x.ndim - 3) + (half,)
    cos = jnp.cos(ang).reshape(shape)
    sin = jnp.sin(ang).reshape(shape)
    xr = x[..., :ROPE_DIM].astype(jnp.float32)
    x1, x2 = xr[..., :half], xr[..., half:]
    rot = jnp.concatenate([x1 * cos - x2 * sin, x2 * cos + x1 * sin], axis=-1)
    return jnp.concatenate([rot.astype(x.dtype), x[..., ROPE_DIM:]], axis=-1)


def _chunk_id(r):
    return jnp.where(r < N_META, -1, (r - N_META) // CHUNK)


def _project(h, pos, w_in, b_f, g_qa, g_ka, g_qb, g_kb):
    bsz, t = h.shape[:2]
    qa, ka, va, qb, kb, vb, fb = jnp.split(h @ w_in, SPLITS, axis=-1)
    qa = _rope(_rmsnorm(qa.reshape(bsz, t, A_HEADS, 2, HEAD_DIM), g_qa), pos)
    ka = _rope(_rmsnorm(ka.reshape(bsz, t, A_HEADS, 2, HEAD_DIM), g_ka), pos)
    va = va.reshape(bsz, t, A_HEADS, A_VDIM)
    qb = _rmsnorm(qb.reshape(bsz, t, B_HEADS, HEAD_DIM), g_qb)
    kb = _rmsnorm(kb.reshape(bsz, t, B_HEADS, HEAD_DIM), g_kb)
    vb = vb.reshape(bsz, t, B_HEADS, HEAD_DIM)
    logf = jax.nn.log_sigmoid((fb + b_f).astype(jnp.float32))
    return qa, ka, va, qb, kb, vb, logf


def _diff_attn(qa, ka, va, mask, lam):
    s = jnp.einsum('bqhmd,bkhmd->bhmqk', qa, ka).astype(jnp.float32) * (HEAD_DIM ** -0.5)
    p = jax.nn.softmax(jnp.where(mask, s, NEG), axis=-1)
    p = p[:, :, 0] - lam * p[:, :, 1]
    return jnp.einsum('bhqk,bkhe->bqhe', p.astype(va.dtype), va)


def _fox_attn(qb, kb, vb, cq, ck, mask):
    s = jnp.einsum('bqhd,bkhd->bhqk', qb, kb).astype(jnp.float32) * (HEAD_DIM ** -0.5)
    s = s + (jnp.transpose(cq, (0, 2, 1))[..., :, None] - jnp.transpose(ck, (0, 2, 1))[..., None, :])
    p = jax.nn.softmax(jnp.where(mask, s, NEG), axis=-1)
    return jnp.einsum('bhqk,bkhe->bqhe', p.astype(vb.dtype), vb)


def _mix_prompt(h, lam, w_in, b_f, g_qa, g_ka, g_qb, g_kb):
    bsz, L = h.shape[:2]
    qa, ka, va, qb, kb, vb, logf = _project(h, jnp.arange(L), w_in, b_f, g_qa, g_ka, g_qb, g_kb)
    c = jnp.cumsum(logf, axis=1)
    n_blk = -(-L // Q_BLOCK)
    Lp = n_blk * Q_BLOCK

    def to_blocks(a):
        a = jnp.pad(a, [(0, 0), (0, Lp - L)] + [(0, 0)] * (a.ndim - 2))
        return jnp.moveaxis(a.reshape((bsz, n_blk, Q_BLOCK) + a.shape[2:]), 1, 0)

    krow = jnp.arange(L)
    kchunk = _chunk_id(krow)

    def block(args):
        qa_b, qb_b, cq_b, start = args
        qrow = start + jnp.arange(Q_BLOCK)
        mask_a = kchunk[None, :] <= _chunk_id(qrow)[:, None]
        mask_b = krow[None, :] <= qrow[:, None]
        return (_diff_attn(qa_b, ka, va, mask_a, lam),
                _fox_attn(qb_b, kb, vb, cq_b, c, mask_b))

    starts = jnp.arange(n_blk) * Q_BLOCK
    oa, ob = lax.map(block, (to_blocks(qa), to_blocks(qb), to_blocks(c), starts))

    def from_blocks(o):
        return jnp.moveaxis(o, 0, 1).reshape((bsz, Lp) + o.shape[3:])[:, :L]

    return from_blocks(oa), from_blocks(ob), (ka, va, kb, vb, logf)


def _mix_sample(h, ck_a, cv_a, ck_b, cv_b, clogf, lam, w_in, b_f, g_qa, g_ka, g_qb, g_kb):
    bsz, t = h.shape[:2]
    past = ck_a.shape[1]
    pos = past + jnp.arange(t)
    qa, ka, va, qb, kb, vb, logf = _project(h, pos, w_in, b_f, g_qa, g_ka, g_qb, g_kb)
    ka_all = jnp.concatenate([ck_a.astype(ka.dtype), ka], axis=1)
    va_all = jnp.concatenate([cv_a.astype(va.dtype), va], axis=1)
    kb_all = jnp.concatenate([ck_b.astype(kb.dtype), kb], axis=1)
    vb_all = jnp.concatenate([cv_b.astype(vb.dtype), vb], axis=1)
    c = jnp.cumsum(jnp.concatenate([clogf.astype(jnp.float32), logf], axis=1), axis=1)
    mask_a = jnp.ones((t, past + t), dtype=bool)
    mask_b = jnp.arange(past + t)[None, :] <= pos[:, None]
    oa = _diff_attn(qa, ka_all, va_all, mask_a, lam)
    ob = _fox_attn(qb, kb_all, vb_all, c[:, past:], c, mask_b)
    return oa, ob, (ka, va, kb, vb, logf)


def _merge(oa, ob, g_oa, g_ob, w_out, lam_init):
    bsz, t = oa.shape[:2]
    oa = _rmsnorm(oa, g_oa) * (1.0 - lam_init)
    ob = _rmsnorm(ob, g_ob)
    return jnp.concatenate([oa.reshape(bsz, t, A_V), ob.reshape(bsz, t, B_QK)], axis=-1) @ w_out


def _layer(x, mixer, lam_init, g_ffn1, f1w1, f1w3, f1w2, g_mix, g_oa, g_ob, w_out,
           g_ffn2, f2w1, f2w3, f2w2, g_final):
    x = x + 0.5 * _swiglu(_rmsnorm(x, g_ffn1), f1w1, f1w3, f1w2)
    oa, ob, new = mixer(_rmsnorm(x, g_mix))
    x = x + _merge(oa, ob, g_oa, g_ob, w_out, lam_init)
    x = x + 0.5 * _swiglu(_rmsnorm(x, g_ffn2), f2w1, f2w3, f2w2)
    return _rmsnorm(x, g_final), new


def setup_inputs(seed: int = 0) -> dict:
    key = jax.random.key(seed)
    ks = iter(jax.random.split(key, 48))

    def nrm(shape, scale):
        return scale * jax.random.normal(next(ks), shape, jnp.float32)

    def gain(shape):
        return 1.0 + nrm(shape, 0.05)

    d = D_MODEL
    return {
        'x_prompt': nrm((BATCH, SEQ, d), 1.0),
        'x_sample': nrm((DEC_BATCH, DEC_SEQ, d), 1.0),
        'cache_a_k': nrm((DEPTH, DEC_BATCH, PAST_LEN, A_HEADS, 2, HEAD_DIM), 1.0),
        'cache_a_v': nrm((DEPTH, DEC_BATCH, PAST_LEN, A_HEADS, A_VDIM), 1.0),
        'cache_b_k': nrm((DEPTH, DEC_BATCH, PAST_LEN, B_HEADS, HEAD_DIM), 1.0),
        'cache_b_v': nrm((DEPTH, DEC_BATCH, PAST_LEN, B_HEADS, HEAD_DIM), 1.0),
        'cache_b_logf': jax.nn.log_sigmoid(FORGET_BIAS + nrm((DEPTH, DEC_BATCH, PAST_LEN, B_HEADS), 1.0)),
        'meta_tokens': nrm((N_META, d), 1.0),
        'g_ffn1': gain((DEPTH, d)),
        'ffn1_w1': nrm((DEPTH, d, D_FF), d ** -0.5),
        'ffn1_w3': nrm((DEPTH, d, D_FF), d ** -0.5),
        'ffn1_w2': nrm((DEPTH, D_FF, d), D_FF ** -0.5),
        'g_mix': gain((DEPTH, d)),
        'w_in': nrm((DEPTH, d, N_IN), d ** -0.5),
        'b_f': FORGET_BIAS + nrm((DEPTH, B_HEADS), 0.1),
        'g_qa': gain((DEPTH, HEAD_DIM)),
        'g_ka': gain((DEPTH, HEAD_DIM)),
        'g_qb': gain((DEPTH, HEAD_DIM)),
        'g_kb': gain((DEPTH, HEAD_DIM)),
        'lambda_q1': nrm((DEPTH, HEAD_DIM), 0.1),
        'lambda_k1': nrm((DEPTH, HEAD_DIM), 0.1),
        'lambda_q2': nrm((DEPTH, HEAD_DIM), 0.1),
        'lambda_k2': nrm((DEPTH, HEAD_DIM), 0.1),
        'g_oa': gain((DEPTH, A_VDIM)),
        'g_ob': gain((DEPTH, HEAD_DIM)),
        'w_out': nrm((DEPTH, A_V + B_QK, d), (A_V + B_QK) ** -0.5),
        'g_ffn2': gain((DEPTH, d)),
        'ffn2_w1': nrm((DEPTH, d, D_FF), d ** -0.5),
        'ffn2_w3': nrm((DEPTH, d, D_FF), d ** -0.5),
        'ffn2_w2': nrm((DEPTH, D_FF, d), D_FF ** -0.5),
        'g_final': gain((DEPTH, d)),
    }


def reference(x_prompt, x_sample, cache_a_k, cache_a_v, cache_b_k, cache_b_v, cache_b_logf,
              meta_tokens, g_ffn1, ffn1_w1, ffn1_w3, ffn1_w2, g_mix, w_in, b_f,
              g_qa, g_ka, g_qb, g_kb, lambda_q1, lambda_k1, lambda_q2, lambda_k2,
              g_oa, g_ob, w_out, g_ffn2, ffn2_w1, ffn2_w3, ffn2_w2, g_final):
    bsz = x_prompt.shape[0]
    meta = jnp.broadcast_to(meta_tokens.astype(x_prompt.dtype)[None], (bsz, N_META, x_prompt.shape[2]))
    xp = jnp.concatenate([meta, x_prompt], axis=1)
    xs = x_sample
    new_p = [[] for _ in range(5)]
    new_s = [[] for _ in range(5)]
    for l in range(DEPTH):
        lam_init = 0.8 - 0.6 * math.exp(-0.3 * l)
        lam = (jnp.exp(jnp.sum(lambda_q1[l].astype(jnp.float32) * lambda_k1[l].astype(jnp.float32)))
               - jnp.exp(jnp.sum(lambda_q2[l].astype(jnp.float32) * lambda_k2[l].astype(jnp.float32)))
               + lam_init)
        proj_w = (w_in[l], b_f[l], g_qa[l], g_ka[l], g_qb[l], g_kb[l])
        rest = (lam_init, g_ffn1[l], ffn1_w1[l], ffn1_w3[l], ffn1_w2[l], g_mix[l], g_oa[l], g_ob[l],
                w_out[l], g_ffn2[l], ffn2_w1[l], ffn2_w3[l], ffn2_w2[l], g_final[l])
        mix_p = functools.partial(_mix_prompt, lam=lam, w_in=proj_w[0], b_f=proj_w[1], g_qa=proj_w[2],
                                  g_ka=proj_w[3], g_qb=proj_w[4], g_kb=proj_w[5])
        mix_s = functools.partial(_mix_sample, ck_a=cache_a_k[l], cv_a=cache_a_v[l], ck_b=cache_b_k[l],
                                  cv_b=cache_b_v[l], clogf=cache_b_logf[l], lam=lam, w_in=proj_w[0],
                                  b_f=proj_w[1], g_qa=proj_w[2], g_ka=proj_w[3], g_qb=proj_w[4],
                                  g_kb=proj_w[5])
        xp, st_p = _layer(xp, mix_p, *rest)
        xs, st_s = _layer(xs, mix_s, *rest)
        for i in range(5):
            new_p[i].append(st_p[i])
            new_s[i].append(st_s[i])
    y_prompt = xp[:, N_META:]
    y_sample = xs
    return (y_prompt, y_sample,
            jnp.stack(new_p[0]), jnp.stack(new_p[1]), jnp.stack(new_p[2]), jnp.stack(new_p[3]), jnp.stack(new_p[4]),
            jnp.stack(new_s[0]), jnp.stack(new_s[1]), jnp.stack(new_s[2]), jnp.stack(new_s[3]), jnp.stack(new_s[4]))
```

```cpp
#include <hip/hip_runtime.h>
#include <cstdio>
#include <cstdint>

#ifndef MK_PER_PHASE
#define MK_PER_PHASE 0
#endif

namespace pg8 {
#define PG8_LAS __attribute__((address_space(3)))
typedef unsigned short bf16_t;
typedef short bf16x8 __attribute__((ext_vector_type(8)));
typedef float f32x4 __attribute__((ext_vector_type(4)));
typedef unsigned u32x4 __attribute__((ext_vector_type(4)));
constexpr int BM = 256, BK = 64, HALF = 128, HTB = HALF * BK * 2  , STAGE_BYTES = 8 * HTB, NXCD = 8, WGM = 8;

__host__ __device__ __forceinline__ int lds_byte(int r, int c) { const int st = (r >> 4) * 2 + (c >> 5), rr = r & 15, cc = c & 31, ob = rr * 64 + cc * 2; return st * 1024 + (ob ^ (((ob >> 9) & 1) << 5)); }
__host__ __device__ __forceinline__ void stage_rc(int b, int& R, int& C) { const int st = b / 1024, sb = b % 1024, swz = sb ^ (((sb >> 9) & 1) << 5); R = (st >> 1) * 16 + swz / 64; C = (st & 1) * 32 + (swz % 64) / 2; }
__host__ __device__ __forceinline__ int perm32(int rho) { const int n = rho >> 4, i = rho & 15; return 8 * (i >> 2) + 4 * n + (i & 3); }

struct Unit { int pm, pn, ko, si; };
struct Gemm { const bf16_t* A; const bf16_t* Bt; int M, N, K, ld; };

struct StaticOrder {
    int nM, nN, nwg, G, c, nr;
    __host__ __device__ __forceinline__ void init(int M, int N, int G_, int c_) { nM = M / BM; nN = N / BM; nwg = nM * nN; G = G_; c = c_; nr = 1 << 30; }
    __host__ __device__ __forceinline__ void decode(int wgid, Unit& u) const {
        { const int q = nwg / NXCD, r = nwg % NXCD, xcd = wgid % NXCD, off = wgid / NXCD; wgid = (xcd < r ? xcd * (q + 1) : r * (q + 1) + (xcd - r) * q) + off; }
        const int nig = WGM * nN, gid = wgid / nig, fm = gid * WGM, gsz = (nM - fm) < WGM ? (nM - fm) : WGM;
        u.pm = fm + ((wgid % nig) % gsz); u.pn = (wgid % nig) / gsz; u.ko = 0; u.si = 0;
    }
    __host__ __device__ __forceinline__ bool next(int i, Unit& u) const {
        const long L = (long)i * G + c; if (L >= nwg || i >= nr) return false;
        decode((int)L, u); return true;
    }
    __device__ __forceinline__ void a_ready(const Unit&) const {}
    __device__ __forceinline__ void done(const Unit&) const {}
};
struct TailOrder {
    StaticOrder S; int base, nitems, split, kpart;
    __host__ __device__ __forceinline__ void init(int M, int N, int G_, int c_, int split_, int kpart_) { S.init(M, N, G_, c_); base = (S.nwg / G_) * G_; split = split_; kpart = kpart_; nitems = (S.nwg - base) * split_; }
    __host__ __device__ __forceinline__ bool next(int i, Unit& u) const {
        const int I = i * S.G + S.c; if (I >= nitems) return false;
        S.decode(base + I / split, u); u.ko = (I % split) * kpart; u.si = I; return true;
    }
    __device__ __forceinline__ void a_ready(const Unit&) const {}
    __device__ __forceinline__ void done(const Unit&) const {}
};
__device__ __forceinline__ unsigned cvt_pk_bf16(float lo, float hi) { unsigned r; asm volatile("v_cvt_pk_bf16_f32 %0, %1, %2" : "=v"(r) : "v"(lo), "v"(hi)); return r; }
typedef unsigned u32x2 __attribute__((ext_vector_type(2)));

constexpr int R_SMP = 32768, R_META = 34816, R_END = 34832;
constexpr int SEQP_ = 8208, PSTR_ = 8256, SSTR_ = 2112, SROW_S0_ = 4 * 8256;

struct EpiSwiGLU {
    static constexpr bool PERM = true, AFTER_DRAIN = false;
    bf16_t* H; int ldh;
    __device__ __forceinline__ void operator()(const f32x4 (&acc)[2][2][4][2], const Unit& u, int wr, int wc, int fr, int fq) const {
        const int row0 = u.pm * BM + wr * 64 + fr, col0 = u.pn * HALF + wc * 32 + 8 * fq;
#pragma unroll
        for (int ai = 0; ai < 2; ++ai)
#pragma unroll
            for (int m = 0; m < 4; ++m) {
                bf16_t* rowp = H + (size_t)(row0 + ai * HALF + m * 16) * ldh + col0;
                float h[8];
#pragma unroll
                for (int n = 0; n < 2; ++n)
#pragma unroll
                    for (int i = 0; i < 4; ++i) { const float g = acc[ai][0][m][n][i], up = acc[ai][1][m][n][i];
                        const float e = __builtin_amdgcn_exp2f(-1.4426950408889634f * g);
                        h[n * 4 + i] = g * __builtin_amdgcn_rcpf(1.0f + e) * up; }
                u32x4 w; w.x = cvt_pk_bf16(h[0], h[1]); w.y = cvt_pk_bf16(h[2], h[3]); w.z = cvt_pk_bf16(h[4], h[5]); w.w = cvt_pk_bf16(h[6], h[7]);
                *(u32x4*)rowp = w;
            }
    }
};

template <int MODE> struct EpiResid {
    static constexpr bool PERM = false, AFTER_DRAIN = false;
    float* out; const float* xp; const float* xs; const float* meta; float alpha;
    __device__ __forceinline__ void operator()(const f32x4 (&acc)[2][2][4][2], const Unit& u, int wr, int wc, int fr, int fq) const {
        const int row0 = u.pm * BM + wr * 64 + fr, col0 = u.pn * BM + wc * 32 + 4 * fq;
#pragma unroll
        for (int ai = 0; ai < 2; ++ai) {
            f32x4 b[4][2][2];
#pragma unroll
            for (int m = 0; m < 4; ++m) {
                const int R = row0 + ai * HALF + m * 16;
                const float* bp;
                if (MODE == 0) bp = out + (size_t)R * 2048 + col0;
                else bp = (R < R_SMP) ? xp + (size_t)R * 2048 + col0 : (R < R_META) ? xs + (size_t)(R - R_SMP) * 2048 + col0 : (R < R_END) ? meta + (size_t)(R - R_META) * 2048 + col0 : nullptr;
#pragma unroll
                for (int bj = 0; bj < 2; ++bj)
#pragma unroll
                    for (int n = 0; n < 2; ++n) { b[m][bj][n] = (f32x4){0.f, 0.f, 0.f, 0.f}; if (MODE == 0 || bp) b[m][bj][n] = *(const f32x4*)(bp + bj * HALF + n * 16); }
            }
            __builtin_amdgcn_sched_barrier(0);
#pragma unroll
            for (int m = 0; m < 4; ++m) {
                float* op = out + (size_t)(row0 + ai * HALF + m * 16) * 2048 + col0;
#pragma unroll
                for (int bj = 0; bj < 2; ++bj)
#pragma unroll
                    for (int n = 0; n < 2; ++n) *(f32x4*)(op + bj * HALF + n * 16) = b[m][bj][n] + acc[ai][bj][m][n] * alpha;
            }
            __builtin_amdgcn_sched_barrier(0);
        }
    }
};

struct EpiSlab {
    static constexpr bool PERM = false, AFTER_DRAIN = false;
    float* slabs;
    __device__ __forceinline__ void operator()(const f32x4 (&acc)[2][2][4][2], const Unit& u, int wr, int wc, int fr, int fq) const {
        float* sb = slabs + (size_t)u.si * 65536 + (size_t)(wr * 64 + fr) * 256 + wc * 32 + 4 * fq;
#pragma unroll
        for (int ai = 0; ai < 2; ++ai)
#pragma unroll
            for (int m = 0; m < 4; ++m)
#pragma unroll
                for (int bj = 0; bj < 2; ++bj)
#pragma unroll
                    for (int n = 0; n < 2; ++n) *(f32x4*)(sb + (size_t)(ai * HALF + m * 16) * 256 + bj * HALF + n * 16) = acc[ai][bj][m][n];
    }
};

struct EpiQKV {
    static constexpr bool PERM = false, AFTER_DRAIN = false;
    float* out; bf16_t* QA; bf16_t* KA; const PG8_LAS float* gains; PG8_LAS float* P;
    size_t q_stride, s_stride, o_p0, o_pstride, o_s0, o_sstride;
    __device__ __forceinline__ void operator()(const f32x4 (&acc)[2][2][4][2], const Unit& u, int wr, int wc, int fr, int fq) const {
        const int grp = u.pn >> 2, tcol = (u.pn & 3) * 256;
        const bool normed = (grp != 2 && grp != 5), roped = grp < 2, isq = (grp == 0 || grp == 3);
        if (normed) {
#pragma unroll
            for (int ai = 0; ai < 2; ++ai)
#pragma unroll
                for (int m = 0; m < 4; ++m)
#pragma unroll
                    for (int bj = 0; bj < 2; ++bj) {
                        const f32x4 a = acc[ai][bj][m][0], b = acc[ai][bj][m][1];
                        float s = (a[0] * a[0] + a[1] * a[1]) + (a[2] * a[2] + a[3] * a[3]) + (b[0] * b[0] + b[1] * b[1]) + (b[2] * b[2] + b[3] * b[3]);
                        s += __shfl_xor(s, 16); s += __shfl_xor(s, 32);
                        if (fq == 0) P[((ai * HALF + wr * 64 + m * 16 + fr) * 2 + bj) * 4 + wc] = s;
                    }
            asm volatile("s_waitcnt lgkmcnt(0)" ::: "memory"); __builtin_amdgcn_s_barrier(); asm volatile("" ::: "memory");
        }
        f32x4 g[2];
        {
            const PG8_LAS float* gv = gains + (grp < 2 ? grp : grp - 1) * 128;
            const float qs = isq ? 0.08838834764831845f * 1.4426950408889634f : 1.0f;
#pragma unroll
            for (int n = 0; n < 2; ++n) g[n] = normed ? *(const PG8_LAS f32x4*)(gv + wc * 32 + n * 16 + 4 * fq) * qs : (f32x4){1.f, 1.f, 1.f, 1.f};
        }
        const int sidx_ = grp - 1 - (grp > 3 ? 1 : 0);
        bf16_t* sbuf = KA + (size_t)(sidx_ < 0 ? 0 : sidx_) * s_stride;
        bf16_t* qbuf = QA + (grp == 3 ? q_stride : 0);
        const size_t o_p = o_p0 + (size_t)(sidx_ < 0 ? 0 : sidx_) * o_pstride;
        const size_t o_s = o_s0 + (size_t)(sidx_ < 0 ? 0 : sidx_) * o_sstride;
        const int colw = tcol + wc * 32 + 4 * fq;
        float rinv[4];
#pragma unroll
        for (int i = 0; i < 4; ++i) rinv[i] = __builtin_amdgcn_exp2f(-(float)(4 * fq + i) * (18.931568569324174f / 16.0f)) * 0.15915494309189535f;
#pragma unroll
        for (int ai = 0; ai < 2; ++ai)
#pragma unroll
            for (int m = 0; m < 4; ++m) {
                const int R = u.pm * BM + ai * HALF + wr * 64 + m * 16 + fr;
                float rstd2[2] = {1.f, 1.f};
                if (normed) {
#pragma unroll
                    for (int bj = 0; bj < 2; ++bj) { const f32x4 q = *(const PG8_LAS f32x4*)(P + ((ai * HALF + wr * 64 + m * 16 + fr) * 2 + bj) * 4);
                        rstd2[bj] = __builtin_amdgcn_rsqf(((q[0] + q[1]) + (q[2] + q[3])) * (1.0f / 128.0f) + 1e-6f); }
                }
                if (R < R_END) {
                f32x4 cs = (f32x4){1.f, 1.f, 1.f, 1.f}, sn = (f32x4){0.f, 0.f, 0.f, 0.f};
                if (roped && wc == 0) {
                    const int pos = (R < R_SMP) ? 16 + (R & 8191) : (R < R_META) ? 2048 + (R & 63) : (R - R_META);
                    const float fp = (float)pos;
#pragma unroll
                    for (int i = 0; i < 4; ++i) { float rev = fp * rinv[i]; rev = __builtin_amdgcn_fractf(rev); cs[i] = __builtin_amdgcn_cosf(rev); sn[i] = __builtin_amdgcn_sinf(rev); }
                }
#pragma unroll
                for (int bj = 0; bj < 2; ++bj) {
                    f32x4 v0 = acc[ai][bj][m][0] * rstd2[bj] * g[0], v1 = acc[ai][bj][m][1] * rstd2[bj] * g[1];
                    if (roped && wc == 0) { const f32x4 x1 = v0, x2 = v1; v0 = x1 * cs - x2 * sn; v1 = x2 * cs + x1 * sn; }
                    const int col = colw + bj * HALF;
                    u32x2 w0, w1; w0.x = cvt_pk_bf16(v0[0], v0[1]); w0.y = cvt_pk_bf16(v0[2], v0[3]); w1.x = cvt_pk_bf16(v1[0], v1[1]); w1.y = cvt_pk_bf16(v1[2], v1[3]);
                    if (isq) {
                        if (R < R_META) { bf16_t* q = qbuf + (size_t)R * 1024 + col; *(u32x2*)q = w0; *(u32x2*)(q + 16) = w1; }
                    } else if (R < R_SMP) {
                        const int b = R >> 13, t = R & 8191;
                        float* o = out + o_p + ((size_t)(b * SEQP_ + 16 + t) * 1024 + col); *(f32x4*)o = v0; *(f32x4*)(o + 16) = v1;
                        bf16_t* s = sbuf + ((size_t)(b * PSTR_ + 64 + t) * 1024 + col); *(u32x2*)s = w0; *(u32x2*)(s + 16) = w1;
                    } else if (R < R_META) {
                        const int sidx = (R - R_SMP) >> 6, i = R & 63;
                        float* o = out + o_s + ((size_t)(R - R_SMP) * 1024 + col); *(f32x4*)o = v0; *(f32x4*)(o + 16) = v1;
                        bf16_t* s = sbuf + ((size_t)(SROW_S0_ + sidx * SSTR_ + 2048 + i) * 1024 + col); *(u32x2*)s = w0; *(u32x2*)(s + 16) = w1;
                    } else {
                        const int mi = R - R_META;
#pragma unroll
                        for (int b = 0; b < 4; ++b) {
                            float* o = out + o_p + ((size_t)(b * SEQP_ + mi) * 1024 + col); *(f32x4*)o = v0; *(f32x4*)(o + 16) = v1;
                            bf16_t* s = sbuf + ((size_t)(b * PSTR_ + mi) * 1024 + col); *(u32x2*)s = w0; *(u32x2*)(s + 16) = w1;
                        }
                    }
                }
                }
                __builtin_amdgcn_sched_barrier(0);
            }
    }
};

template <class Epi, class Sched, bool ALIGN_EPI = false, bool SP2 = false>
__device__ __forceinline__ void gemm_phase(PG8_LAS unsigned char* lds, const Gemm g, const Sched& S, const Epi& E) {
    const int tid = threadIdx.x, wid = __builtin_amdgcn_readfirstlane(tid >> 6), lane = tid & 63, wr = wid >> 2, wc = wid & 3, fr = lane & 15, fq = lane >> 4;
    const int K = g.ld, nt = g.K / BK;
    unsigned voffA[2], voffB[2];
#pragma unroll
    for (int i = 0; i < 2; ++i) { int R, C; stage_rc(tid * 16 + i * 8192, R, C); const int Rb = Epi::PERM ? ((R & ~31) + perm32(R & 31)) : R;
        voffA[i] = (unsigned)(R * K + C) * 2u; voffB[i] = (unsigned)(Rb * K + C) * 2u; }
    const size_t kstep = (size_t)(BK * 2);
    const size_t hstep = (size_t)HALF * K * 2;
    const size_t tstep = 2 * hstep;
    const unsigned ldsw = (unsigned)wid * 1024u;
    const int aoff = lds_byte(wr * 64 + fr, fq * 8), boff = lds_byte(wc * 32 + fr, fq * 8);
#define PG8_SA(b, h) (((b) * 2 + (h)) * HTB)
#define PG8_SB(b, h) ((4 + (b) * 2 + (h)) * HTB)
#define PG8_STAGE(bufoff, gbase, voff) do { _Pragma("unroll") for (int _i = 0; _i < 2; ++_i) \
        __builtin_amdgcn_global_load_lds((const unsigned*)((const char*)(gbase) + (voff)[_i]), (PG8_LAS unsigned*)(lds + (bufoff) + ldsw + _i * 8192), 16, 0, 0); } while (0)
#define PG8_LDA(dst, b, h) do { _Pragma("unroll") for (int m = 0; m < 4; ++m) _Pragma("unroll") for (int k = 0; k < 2; ++k) dst[m][k] = *(const PG8_LAS bf16x8*)(lds + PG8_SA(b, h) + aoff + m * 2048 + k * 1024); } while (0)
#define PG8_LDB(dst, b, h) do { _Pragma("unroll") for (int n = 0; n < 2; ++n) _Pragma("unroll") for (int k = 0; k < 2; ++k) dst[n][k] = *(const PG8_LAS bf16x8*)(lds + PG8_SB(b, h) + boff + n * 2048 + k * 1024); } while (0)
#define PG8_MMA(ai, bj, At, Bt) do { __builtin_amdgcn_s_setprio(1); _Pragma("unroll") for (int m = 0; m < 4; ++m) _Pragma("unroll") for (int n = 0; n < 2; ++n) _Pragma("unroll") for (int k = 0; k < 2; ++k) \
        acc[ai][bj][m][n] = __builtin_amdgcn_mfma_f32_16x16x32_bf16(Bt[n][k], At[m][k], acc[ai][bj][m][n], 0, 0, 0); __builtin_amdgcn_s_setprio(0); } while (0)
#define PG8_WAIT_V(n) asm volatile("s_waitcnt vmcnt(" #n ")" ::: "memory")
#define PG8_WAIT_L(n) asm volatile("s_waitcnt lgkmcnt(" #n ")" ::: "memory")
#define PG8_BAR __builtin_amdgcn_s_barrier()
#define PG8_SCHED __builtin_amdgcn_sched_barrier(0)
    Unit cur, nxt; int ui = 0;
    if (!S.next(0, cur)) return;
    f32x4 acc[2][2][4][2];
#pragma unroll
    for (int a = 0; a < 2; ++a)
#pragma unroll
        for (int b = 0; b < 2; ++b)
#pragma unroll
            for (int m = 0; m < 4; ++m)
#pragma unroll
                for (int n = 0; n < 2; ++n) acc[a][b][m][n] = (f32x4){0.f, 0.f, 0.f, 0.f};
    bf16x8 At[4][2], B0[2][2], B1[2][2];
    const char* cA = (const char*)g.A + (size_t)cur.pm * tstep + (size_t)cur.ko * 2; const char* cB = (const char*)g.Bt + (size_t)cur.pn * tstep + (size_t)cur.ko * 2;
    S.a_ready(cur);
    if constexpr (SP2) {
        PG8_STAGE(PG8_SB(0, 0), cB, voffB); PG8_STAGE(PG8_SB(0, 1), cB + hstep, voffB); PG8_STAGE(PG8_SA(0, 0), cA, voffA); PG8_STAGE(PG8_SA(0, 1), cA + hstep, voffA);
        if (wr == 1) PG8_BAR;
        PG8_WAIT_V(2); PG8_BAR;
        PG8_STAGE(PG8_SB(1, 0), cB + kstep, voffB); PG8_STAGE(PG8_SA(1, 0), cA + kstep, voffA); PG8_STAGE(PG8_SB(1, 1), cB + hstep + kstep, voffB);
        PG8_WAIT_V(6); PG8_BAR;
    } else {
        PG8_STAGE(PG8_SB(0, 0), cB, voffB); PG8_STAGE(PG8_SA(0, 0), cA, voffA); PG8_STAGE(PG8_SB(0, 1), cB + hstep, voffB); PG8_STAGE(PG8_SA(0, 1), cA + hstep, voffA);
        if (wr == 1) PG8_BAR;
        PG8_WAIT_V(4); PG8_BAR;
        PG8_STAGE(PG8_SB(1, 0), cB + kstep, voffB); PG8_STAGE(PG8_SA(1, 0), cA + kstep, voffA); PG8_STAGE(PG8_SB(1, 1), cB + hstep + kstep, voffB);
        PG8_WAIT_V(6); PG8_BAR;
    }
    for (;;) {
        const bool has_next = S.next(ui + 1, nxt);
        const char* nA = has_next ? (const char*)g.A + (size_t)nxt.pm * tstep + (size_t)nxt.ko * 2 : cA; const char* nB = has_next ? (const char*)g.Bt + (size_t)nxt.pn * tstep + (size_t)nxt.ko * 2 : cB;
        for (int t = 0; t < nt; t += 2) {
            const bool last = (t == nt - 2);
            const char* a1 = cA + (size_t)(t + 1) * kstep;
            const char* a2 = last ? nA : cA + (size_t)(t + 2) * kstep; const char* b2 = last ? nB : cB + (size_t)(t + 2) * kstep;
            const char* a3 = a2 + kstep; const char* b3 = b2 + kstep;
            if (last && has_next) S.a_ready(nxt);
            if constexpr (SP2) {
            PG8_LDB(B0, 0, 0); PG8_LDB(B1, 0, 1); PG8_SCHED; PG8_LDA(At, 0, 0); PG8_STAGE(PG8_SA(1, 1), a1 + hstep, voffA);
            PG8_WAIT_V(8); PG8_WAIT_L(0); PG8_BAR; PG8_MMA(0, 0, At, B0); PG8_MMA(0, 1, At, B1); PG8_BAR; PG8_SCHED;
            PG8_LDA(At, 0, 1); PG8_STAGE(PG8_SB(0, 0), b2, voffB); PG8_STAGE(PG8_SB(0, 1), b2 + hstep, voffB); PG8_STAGE(PG8_SA(0, 0), a2, voffA);
            PG8_WAIT_V(8); PG8_WAIT_L(0); PG8_BAR; PG8_MMA(1, 0, At, B0); PG8_MMA(1, 1, At, B1); PG8_BAR; PG8_SCHED;
            PG8_LDB(B0, 1, 0); PG8_LDB(B1, 1, 1); PG8_SCHED; PG8_LDA(At, 1, 0); PG8_STAGE(PG8_SA(0, 1), a2 + hstep, voffA);
            PG8_WAIT_V(8); PG8_WAIT_L(0); PG8_BAR; PG8_MMA(0, 0, At, B0); PG8_MMA(0, 1, At, B1); PG8_BAR; PG8_SCHED;
            PG8_LDA(At, 1, 1); PG8_STAGE(PG8_SB(1, 0), b3, voffB); PG8_STAGE(PG8_SB(1, 1), b3 + hstep, voffB); PG8_STAGE(PG8_SA(1, 0), a3, voffA);
            PG8_WAIT_V(8); PG8_WAIT_L(0); PG8_BAR; PG8_MMA(1, 0, At, B0); PG8_MMA(1, 1, At, B1); PG8_BAR; PG8_SCHED;
            } else {
            PG8_LDB(B0, 0, 0); PG8_SCHED; PG8_LDA(At, 0, 0); PG8_STAGE(PG8_SA(1, 1), a1 + hstep, voffA);
            PG8_WAIT_L(8); PG8_BAR; PG8_WAIT_L(0); PG8_MMA(0, 0, At, B0); PG8_BAR; PG8_SCHED;
            PG8_LDB(B1, 0, 1); PG8_STAGE(PG8_SB(0, 0), b2, voffB);
            PG8_BAR; PG8_WAIT_L(0); PG8_MMA(0, 1, At, B1); PG8_BAR;
            PG8_LDA(At, 0, 1); PG8_STAGE(PG8_SA(0, 0), a2, voffA);
            PG8_BAR; PG8_WAIT_L(0); PG8_MMA(1, 0, At, B0); PG8_BAR; PG8_SCHED;
            PG8_STAGE(PG8_SB(0, 1), b2 + hstep, voffB);
            PG8_WAIT_V(6); PG8_BAR; PG8_MMA(1, 1, At, B1); PG8_BAR;
            PG8_LDB(B0, 1, 0); PG8_SCHED; PG8_LDA(At, 1, 0); PG8_STAGE(PG8_SA(0, 1), a2 + hstep, voffA);
            PG8_WAIT_L(8); PG8_BAR; PG8_WAIT_L(0); PG8_MMA(0, 0, At, B0); PG8_BAR; PG8_SCHED;
            PG8_LDB(B1, 1, 1); PG8_STAGE(PG8_SB(1, 0), b3, voffB);
            PG8_BAR; PG8_WAIT_L(0); PG8_MMA(0, 1, At, B1); PG8_BAR;
            PG8_LDA(At, 1, 1); PG8_STAGE(PG8_SA(1, 0), a3, voffA);
            PG8_BAR; PG8_WAIT_L(0); PG8_MMA(1, 0, At, B0); PG8_BAR; PG8_SCHED;
            PG8_STAGE(PG8_SB(1, 1), b3 + hstep, voffB);
            PG8_WAIT_V(6); PG8_BAR; PG8_MMA(1, 1, At, B1); PG8_BAR;
            }
        }
        if constexpr (ALIGN_EPI) { if (wr == 0) PG8_BAR; }
        if constexpr (!Epi::AFTER_DRAIN) { E(acc, cur, wr, wc, fr, fq); S.done(cur); }
        if (!has_next) break;
#pragma unroll
        for (int a = 0; a < 2; ++a)
#pragma unroll
            for (int b = 0; b < 2; ++b)
#pragma unroll
                for (int m = 0; m < 4; ++m)
#pragma unroll
                    for (int n = 0; n < 2; ++n) acc[a][b][m][n] = (f32x4){0.f, 0.f, 0.f, 0.f};
        cur = nxt; cA = nA; cB = nB; ++ui;
        if constexpr (ALIGN_EPI) { if (wr == 1) PG8_BAR; }
    }
    PG8_WAIT_V(0);
    if constexpr (!ALIGN_EPI) { if (wr == 0) PG8_BAR; }
    PG8_BAR;
    if constexpr (Epi::AFTER_DRAIN) { E.fused(acc, cur, wr, wc, fr, fq, lds, wid, lane); S.done(cur); }
#undef PG8_SA
#undef PG8_SB
#undef PG8_STAGE
#undef PG8_LDA
#undef PG8_LDB
#undef PG8_MMA
#undef PG8_WAIT_V
#undef PG8_WAIT_L
#undef PG8_BAR
#undef PG8_SCHED
}
}
namespace att {
#define ALAS __attribute__((address_space(3)))
typedef unsigned short bf16;
typedef short bf16x8 __attribute__((ext_vector_type(8)));
typedef short s16x4 __attribute__((ext_vector_type(4)));
typedef float f32x16 __attribute__((ext_vector_type(16)));
typedef float f32x4 __attribute__((ext_vector_type(4)));
typedef unsigned u32x4 __attribute__((ext_vector_type(4)));
#define KSWZ(row, colB) ((row) * 256 + ((colB) ^ (((row) & 7) << 4)))
#define ASBAR() __builtin_amdgcn_sched_barrier(0)
__device__ __forceinline__ int crow(int r, int hi) { return (r & 3) + 8 * (r >> 2) + 4 * hi; }
__device__ __forceinline__ unsigned cvtpk(float lo, float hi) { unsigned r; asm volatile("v_cvt_pk_bf16_f32 %0, %1, %2" : "=v"(r) : "v"(lo), "v"(hi)); return r; }
__device__ __forceinline__ int v_rd_base(int lane) { return ((lane & 3) << 3) | (((lane >> 2) & 3) << 6) | (((lane >> 4) & 1) << 5) | (((lane >> 5) & 1) << 8); }
constexpr int v_rd_off(int d0, int ks, int half) { return d0 * 512 + ks * 4096 + half * 2048; }
template <int OFF> __device__ __forceinline__ s16x4 tr_read(int vb) { s16x4 r; asm volatile("ds_read_b64_tr_b16 %0, %1 offset:%2" : "=&v"(r) : "v"(vb), "i"(OFF) : "memory"); return r; }
template <int D0> __device__ __forceinline__ void pv_one(f32x16& od, int vb, bf16x8 pa0, bf16x8 pa1, bf16x8 pa2, bf16x8 pa3) {
    const s16x4 l0 = tr_read<v_rd_off(D0, 0, 0)>(vb), h0 = tr_read<v_rd_off(D0, 0, 1)>(vb), l1 = tr_read<v_rd_off(D0, 1, 0)>(vb), h1 = tr_read<v_rd_off(D0, 1, 1)>(vb);
    const s16x4 l2 = tr_read<v_rd_off(D0, 2, 0)>(vb), h2 = tr_read<v_rd_off(D0, 2, 1)>(vb), l3 = tr_read<v_rd_off(D0, 3, 0)>(vb), h3 = tr_read<v_rd_off(D0, 3, 1)>(vb);
    asm volatile("s_waitcnt lgkmcnt(0)" ::: "memory"); ASBAR();
#define APK(L, H) (bf16x8){L[0], L[1], L[2], L[3], H[0], H[1], H[2], H[3]}
    od = __builtin_amdgcn_mfma_f32_32x32x16_bf16(pa0, APK(l0, h0), od, 0, 0, 0);
    od = __builtin_amdgcn_mfma_f32_32x32x16_bf16(pa1, APK(l1, h1), od, 0, 0, 0);
    od = __builtin_amdgcn_mfma_f32_32x32x16_bf16(pa2, APK(l2, h2), od, 0, 0, 0);
    od = __builtin_amdgcn_mfma_f32_32x32x16_bf16(pa3, APK(l3, h3), od, 0, 0, 0);
#undef APK
}

template <int OFF> __device__ __forceinline__ bf16x8 lds_rd128(int addr) { bf16x8 r; asm volatile("ds_read_b128 %0, %1 offset:%2" : "=&v"(r) : "v"(addr), "i"(OFF) : "memory"); return r; }
template <int D0> struct QkChain {
    static __device__ __forceinline__ void run(f32x16& p0, f32x16& p1, const bf16x8 (&qr)[8], const int (&ka)[4], bf16x8 ca, bf16x8 cb) {
        bf16x8 na, nb;
        if constexpr (D0 < 7) { na = lds_rd128<((D0 + 1) >> 2) * 128>(ka[(D0 + 1) & 3]); nb = lds_rd128<((D0 + 1) >> 2) * 128 + 8192>(ka[(D0 + 1) & 3]); asm volatile("s_waitcnt lgkmcnt(2)" ::: "memory"); }
        else { asm volatile("s_waitcnt lgkmcnt(0)" ::: "memory"); }
        ASBAR();
        p0 = __builtin_amdgcn_mfma_f32_32x32x16_bf16(ca, qr[D0], p0, 0, 0, 0);
        p1 = __builtin_amdgcn_mfma_f32_32x32x16_bf16(cb, qr[D0], p1, 0, 0, 0);
        ASBAR();
        if constexpr (D0 < 7) QkChain<D0 + 1>::run(p0, p1, qr, ka, na, nb);
    }
};
template <int B> __device__ __forceinline__ void tr8(s16x4 (&f)[8], int vb) {
    constexpr int base = (B >> 2) * 16384, D0 = B & 3;
    f[0] = tr_read<base + v_rd_off(D0, 0, 0)>(vb); f[1] = tr_read<base + v_rd_off(D0, 0, 1)>(vb); f[2] = tr_read<base + v_rd_off(D0, 1, 0)>(vb); f[3] = tr_read<base + v_rd_off(D0, 1, 1)>(vb);
    f[4] = tr_read<base + v_rd_off(D0, 2, 0)>(vb); f[5] = tr_read<base + v_rd_off(D0, 2, 1)>(vb); f[6] = tr_read<base + v_rd_off(D0, 3, 0)>(vb); f[7] = tr_read<base + v_rd_off(D0, 3, 1)>(vb);
}
__device__ __forceinline__ void pv4(f32x16& od, const s16x4 (&f)[8], bf16x8 pa0, bf16x8 pa1, bf16x8 pa2, bf16x8 pa3) {
#define APK(L, H) (bf16x8){L[0], L[1], L[2], L[3], H[0], H[1], H[2], H[3]}
    od = __builtin_amdgcn_mfma_f32_32x32x16_bf16(pa0, APK(f[0], f[1]), od, 0, 0, 0);
    od = __builtin_amdgcn_mfma_f32_32x32x16_bf16(pa1, APK(f[2], f[3]), od, 0, 0, 0);
    od = __builtin_amdgcn_mfma_f32_32x32x16_bf16(pa2, APK(f[4], f[5]), od, 0, 0, 0);
    od = __builtin_amdgcn_mfma_f32_32x32x16_bf16(pa3, APK(f[6], f[7]), od, 0, 0, 0);
#undef APK
}
template <int NB, int B = 0> struct PvChain {
    static __device__ __forceinline__ void run(f32x16* o, int vb, s16x4 (&cur)[8], bf16x8 pa0, bf16x8 pa1, bf16x8 pa2, bf16x8 pa3) {
        s16x4 nxt[8];
        if constexpr (B + 1 < NB) { tr8<B + 1>(nxt, vb); asm volatile("s_waitcnt lgkmcnt(8)" ::: "memory"); }
        else { asm volatile("s_waitcnt lgkmcnt(0)" ::: "memory"); }
        ASBAR();
        pv4(o[B], cur, pa0, pa1, pa2, pa3);
        ASBAR();
        if constexpr (B + 1 < NB) PvChain<NB, B + 1>::run(o, vb, nxt, pa0, pa1, pa2, pa3);
    }
};
template <int NB> __device__ __forceinline__ void pv_all(f32x16* o, int vb, bf16x8 pa0, bf16x8 pa1, bf16x8 pa2, bf16x8 pa3) {
    s16x4 f0[8]; tr8<0>(f0, vb);
    PvChain<NB, 0>::run(o, vb, f0, pa0, pa1, pa2, pa3);
}

constexpr int A_RING = 131072;
constexpr int A_WS = 131072 + 256;
constexpr int A_CK = A_WS + 2048;
constexpr int A_QW = 131072 + 16;
constexpr float THR2 = 11.5f;

template <int PPR, int NPT> __device__ __forceinline__ void conv_tile(const float* __restrict__ ck, const float* __restrict__ cv, bf16* __restrict__ dk, bf16* __restrict__ dv, int tile, int ct, int nct) {
    constexpr int NP = 64 * PPR;
    f32x4 x[2 * NPT];
#pragma unroll
    for (int u = 0; u < NPT; ++u) { const int p = ct + u * nct;
        if (p < 2 * NP) { const int q = p % NP; const float* src = ((p < NP) ? ck : cv) + (size_t)(64 * tile + q / PPR) * 1024 + (q % PPR) * 8; x[2 * u] = *(const f32x4*)src; x[2 * u + 1] = *(const f32x4*)(src + 4); } }
#pragma unroll
    for (int u = 0; u < NPT; ++u) { const int p = ct + u * nct;
        if (p < 2 * NP) { const int q = p % NP; bf16* dst = ((p < NP) ? dk : dv) + (size_t)(64 * tile + q / PPR) * 1024 + (q % PPR) * 8;
            u32x4 w = {cvtpk(x[2 * u][0], x[2 * u][1]), cvtpk(x[2 * u][2], x[2 * u][3]), cvtpk(x[2 * u + 1][0], x[2 * u + 1][1]), cvtpk(x[2 * u + 1][2], x[2 * u + 1][3])};
            *(u32x4*)dst = w; } }
}

struct UnitP {
    int kind;
    int h;
    long orow0;
    long srow0;
    int ntiles;
    int qb;
};

template <int DV, bool FOX>
__device__ __forceinline__ void attn_unit(ALAS unsigned char* lds, const UnitP U, const bf16* __restrict__ Qg, const bf16* __restrict__ Kg, const bf16* __restrict__ Vg,
                                          const float* __restrict__ cT, const float* __restrict__ gout, float lam, float prune_thr, bf16* __restrict__ merged,
                                          const float* __restrict__ cacheK, const float* __restrict__ cacheV, int wid, int lane) {
    constexpr int NS = DV / 128;
    constexpr int STAGE = 2 * NS * 16384;
    asm volatile("" : "+v"(lane));
    const int r32 = lane & 31, hi = lane >> 5;
    const bool sample = U.kind >= 2;
    const int rg = (DV == 256) ? (wid & 3) : wid, map = (DV == 256) ? (wid >> 2) : 0;
    const bool active = sample ? (rg < 2) : true;
    int wlast, jd, dq0; const int lim0 = sample ? 63 : 15;
    if (DV == 256) { wlast = sample ? 32 : (2 * U.qb + 1 + (rg >> 1)); jd = -1; dq0 = 0; }
    else { jd = sample ? 32 : (1 + 4 * U.qb + (wid >> 1)); wlast = jd; dq0 = sample ? 32 * wid : 32 * (wid & 1); }
    const int qcol = (DV == 256) ? (U.h * 256 + map * 128) : U.h * 128;
    const int kcol = (DV == 256) ? U.h * 256 : U.h * 128, vcol = kcol;
    unsigned kofs[2], vofs[2];
#pragma unroll
    for (int i = 0; i < 2; ++i) {
        const int pi = 64 * (wid + 8 * i) + lane;
        const int row = pi >> 4, ch = (pi & 15) ^ (row & 7); kofs[i] = (unsigned)(row * 1024 + ch * 8) * 2u;
        const int sub = pi >> 5, rem = pi & 31, kk = (sub >> 2) * 8 + (rem >> 2), c = (sub & 3) * 32 + (rem & 3) * 8;
        const int k = (kk & ~0xC) | ((kk & 4) << 1) | ((kk & 8) >> 1); vofs[i] = (unsigned)(k * 1024 + c) * 2u;
    }
    const float* ck = nullptr; const float* cv = nullptr; bf16* dk = nullptr; bf16* dv = nullptr;
    if (sample) {
        const int sidx = (int)((U.srow0 - 33024) / 2112);
        ck = cacheK + (size_t)sidx * 2048 * 1024 + kcol; cv = cacheV + (size_t)sidx * 2048 * 1024 + vcol;
        dk = (bf16*)Kg + (size_t)U.srow0 * 1024 + kcol; dv = (bf16*)Vg + (size_t)U.srow0 * 1024 + vcol;
        const int tid = wid * 64 + lane;
        conv_tile<16 * NS, (2 * 64 * 16 * NS + 511) / 512>(ck, cv, dk, dv, 0, tid, 512);
        conv_tile<16 * NS, (2 * 64 * 16 * NS + 511) / 512>(ck, cv, dk, dv, 1, tid, 512);
        asm volatile("s_waitcnt vmcnt(0)" ::: "memory"); __builtin_amdgcn_s_barrier();
        __builtin_amdgcn_fence(__ATOMIC_ACQUIRE, "agent"); asm volatile("s_waitcnt vmcnt(0)" ::: "memory");
    }
    const char* kbase = (const char*)Kg + ((size_t)U.srow0 * 1024 + kcol) * 2;
    const char* vbase = (const char*)Vg + ((size_t)U.srow0 * 1024 + vcol) * 2;
    const float* cth = FOX ? cT + (size_t)U.h * 100608 + U.srow0 : nullptr;
#define A_ISSUE(j, s) do { const size_t _to = (size_t)(j) * (64 * 1024 * 2); \
        _Pragma("unroll") for (int _ks = 0; _ks < NS; ++_ks) _Pragma("unroll") for (int _i = 0; _i < 2; ++_i) \
            __builtin_amdgcn_global_load_lds((const unsigned*)(kbase + _to + _ks * 256 + kofs[_i]), (ALAS unsigned*)(lds + (s) * STAGE + _ks * 16384 + (wid + 8 * _i) * 1024), 16, 0, 0); \
        _Pragma("unroll") for (int _vs = 0; _vs < NS; ++_vs) _Pragma("unroll") for (int _i = 0; _i < 2; ++_i) \
            __builtin_amdgcn_global_load_lds((const unsigned*)(vbase + _to + _vs * 256 + vofs[_i]), (ALAS unsigned*)(lds + (s) * STAGE + (NS + _vs) * 16384 + (wid + 8 * _i) * 1024), 16, 0, 0); \
        if (FOX && wid == 0) __builtin_amdgcn_global_load_lds((const unsigned*)(cth + (j) * 64 + lane), (ALAS unsigned*)(lds + A_CK + (s) * 256), 4, 0, 0); } while (0)
    if (sample && !active) {
        constexpr int NCONV = (DV == 256) ? 4 : 6;
        const int cw = (DV == 256) ? ((wid >> 2) * 2 + (wid & 3) - 2) : (wid - 2), ct = cw * 64 + lane;
        A_ISSUE(0, 0);
        for (int j = 0; j < U.ntiles; ++j) {
            const int s = j & 1;
            asm volatile("s_waitcnt vmcnt(0)" ::: "memory"); __builtin_amdgcn_s_barrier(); asm volatile("" ::: "memory");
            if (j + 1 < U.ntiles) A_ISSUE(j + 1, s ^ 1);
            if (j + 2 < 32) conv_tile<16 * NS, (2 * 64 * 16 * NS + 64 * NCONV - 1) / (64 * NCONV)>(ck, cv, dk, dv, j + 2, ct, 64 * NCONV);
        }
        asm volatile("s_waitcnt vmcnt(0) lgkmcnt(0)" ::: "memory");
        __builtin_amdgcn_s_barrier();
        if constexpr (DV == 256) { __builtin_amdgcn_s_barrier(); __builtin_amdgcn_s_barrier(); }
        return;
    }
    bf16x8 qr[8];
    if (active) {
        const bf16* Qw = Qg + (size_t)(U.orow0 + rg * 32 + r32) * 1024 + qcol + hi * 8;
#pragma unroll
        for (int d0 = 0; d0 < 8; ++d0) qr[d0] = *(const bf16x8*)(Qw + d0 * 16);
    } else {
#pragma unroll
        for (int d0 = 0; d0 < 8; ++d0) qr[d0] = (bf16x8){0, 0, 0, 0, 0, 0, 0, 0};
    }
    float m_reg = -1e30f, l_reg = 0.f;
    f32x16 o[DV / 32];
#pragma unroll
    for (int d = 0; d < DV / 32; ++d) o[d] = (f32x16){};
    ALAS float* ws = (ALAS float*)(lds + A_WS) + wid * 64;
    const int vb0 = (int)(unsigned)(uintptr_t)(lds + NS * 16384) + v_rd_base(lane);
    int kx[4];
#pragma unroll
    for (int d = 0; d < 4; ++d) kx[d] = r32 * 256 + ((d * 32 + hi * 16) ^ ((r32 & 7) << 4));

    int j0 = 0;
    if (FOX && !sample) {
        const float ci0 = cth[64 + 256 * U.qb];
        int first = U.ntiles - 1;
        for (int base = 1; base < U.ntiles; base += 64) {
            const int jj = base + lane; bool ok = false;
            if (jj < U.ntiles) ok = (ci0 - cth[64 * jj + 63]) + prune_thr >= 0.f;
            const unsigned long long bm = __ballot(ok);
            if (bm) { first = base + (int)__builtin_ctzll(bm); break; }
        }
        first = __builtin_amdgcn_readfirstlane(first);
        j0 = (first <= 1) ? 0 : first;
    }
    if (wid < 4) __builtin_amdgcn_s_setprio(2);
    A_ISSUE(j0, j0 & 1);
    for (int j = j0; j < U.ntiles; ++j) {
        const int s = j & 1;
        asm volatile("s_waitcnt vmcnt(0)" ::: "memory"); __builtin_amdgcn_s_barrier(); asm volatile("" ::: "memory");
        if (j + 1 < U.ntiles) A_ISSUE(j + 1, s ^ 1);
        if (active && j <= wlast) {
            const ALAS char* Ks = (const ALAS char*)(lds + s * STAGE + map * 16384);
            f32x16 p0 = (f32x16){}, p1 = (f32x16){};
            {
                int ka[4];
#pragma unroll
                for (int i = 0; i < 4; ++i) ka[i] = (int)(unsigned)(uintptr_t)Ks + kx[i];
                bf16x8 k0a = lds_rd128<0>(ka[0]), k0b = lds_rd128<8192>(ka[0]);
                QkChain<0>::run(p0, p1, qr, ka, k0a, k0b);
            }
            if (FOX) {
                const ALAS float* ckp = (const ALAS float*)(lds + A_CK + s * 256) + 4 * hi;
#pragma unroll
                for (int g = 0; g < 4; ++g) {
                    const f32x4 c0 = *(const ALAS f32x4*)(ckp + 8 * g), c1 = *(const ALAS f32x4*)(ckp + 32 + 8 * g);
#pragma unroll
                    for (int i = 0; i < 4; ++i) { p0[4 * g + i] -= c0[i]; p1[4 * g + i] -= c1[i]; }
                }
            }
            if ((j == 0 && lim0 < 63) || j == jd) {
                int lim = 63; if (j == 0) lim = lim0; if (j == jd) { const int l2 = dq0 + r32; lim = l2 < lim ? l2 : lim; }
                const int limh = lim - 4 * hi;
                const float NEG = -__builtin_inff();
#pragma unroll
                for (int r = 0; r < 16; ++r) { const int cr = (r & 3) + 8 * (r >> 2); if (cr > limh) p0[r] = NEG; if (cr + 32 > limh) p1[r] = NEG; }
            }
            float pmax = p0[0];
#pragma unroll
            for (int r = 1; r < 16; ++r) pmax = fmaxf(pmax, p0[r]);
#pragma unroll
            for (int r = 0; r < 16; ++r) pmax = fmaxf(pmax, p1[r]);
            { auto rr = __builtin_amdgcn_permlane32_swap(__float_as_uint(pmax), __float_as_uint(pmax), false, false); pmax = fmaxf(__uint_as_float(rr[0]), __uint_as_float(rr[1])); }
            float mn, alpha;
            if (__all(pmax - m_reg <= THR2)) { mn = m_reg; alpha = 1.f; }
            else { mn = fmaxf(m_reg, pmax); alpha = __builtin_amdgcn_exp2f(m_reg - mn); m_reg = mn; }
#pragma unroll
            for (int r = 0; r < 16; ++r) { p0[r] = __builtin_amdgcn_exp2f(p0[r] - mn); p1[r] = __builtin_amdgcn_exp2f(p1[r] - mn); }
            if (__any(alpha < 1.f)) {
                if (hi == 0) ws[r32] = alpha;
                asm volatile("s_waitcnt lgkmcnt(0)" ::: "memory");
#pragma unroll
                for (int r = 0; r < 16; ++r) { const float a = ws[crow(r, hi)];
#pragma unroll
                    for (int d = 0; d < DV / 32; ++d) o[d][r] *= a; }
            }
            float ps = 0.f;
#pragma unroll
            for (int r = 0; r < 16; ++r) ps += p0[r] + p1[r];
            { auto rr = __builtin_amdgcn_permlane32_swap(__float_as_uint(ps), __float_as_uint(ps), false, false); ps = __uint_as_float(rr[0]) + __uint_as_float(rr[1]); }
            l_reg = l_reg * alpha + ps;
            bf16x8 pa0, pa1, pa2, pa3;
#define PK4(P, B_, OUT) do { unsigned a0 = cvtpk(P[B_ + 0], P[B_ + 1]), a1 = cvtpk(P[B_ + 2], P[B_ + 3]); unsigned b0_ = cvtpk(P[B_ + 4], P[B_ + 5]), b1_ = cvtpk(P[B_ + 6], P[B_ + 7]); \
        auto r0 = __builtin_amdgcn_permlane32_swap(a0, b0_, false, false); auto r1 = __builtin_amdgcn_permlane32_swap(a1, b1_, false, false); \
        u32x4 w = {r0[0], r1[0], r0[1], r1[1]}; OUT = *reinterpret_cast<bf16x8*>(&w); } while (0)
            PK4(p0, 0, pa0); PK4(p0, 8, pa1); PK4(p1, 0, pa2); PK4(p1, 8, pa3);
#undef PK4
            const int vb = vb0 + s * STAGE;
            pv_all<DV / 32>(o, vb, pa0, pa1, pa2, pa3);
        }
    }
#undef A_ISSUE
    __builtin_amdgcn_s_setprio(0);
    float rli[16];
    if (active) {
        if (hi == 0) ws[r32] = l_reg;
        asm volatile("s_waitcnt lgkmcnt(0)" ::: "memory");
#pragma unroll
        for (int r = 0; r < 16; ++r) rli[r] = __builtin_amdgcn_rcpf(ws[crow(r, hi)]);
    }
    asm volatile("s_waitcnt lgkmcnt(0)" ::: "memory"); __builtin_amdgcn_s_barrier(); asm volatile("" ::: "memory");
    if constexpr (DV == 256) {
        ALAS float* X = (ALAS float*)lds + (size_t)rg * (32 * 256);
        if (active && map == 1) {
            int xw = (4 * hi) * 256 + r32; asm volatile("" : "+v"(xw));
#pragma unroll
            for (int r = 0; r < 16; ++r)
#pragma unroll
                for (int d = 0; d < 8; ++d) X[xw + ((r & 3) + 8 * (r >> 2)) * 256 + d * 32] = o[d][r] * rli[r];
        }
        asm volatile("s_waitcnt lgkmcnt(0)" ::: "memory"); __builtin_amdgcn_s_barrier(); asm volatile("" ::: "memory");
        if (active && map == 0) {
            float ss[16];
            int xo = (4 * hi) * 256 + r32; asm volatile("" : "+v"(xo));
#pragma unroll
            for (int r = 0; r < 16; ++r) { float a = 0.f;
#pragma unroll
                for (int d = 0; d < 8; ++d) { const float v = o[d][r] * rli[r] - lam * X[xo + ((r & 3) + 8 * (r >> 2)) * 256 + d * 32]; o[d][r] = v; a += v * v; }
                ss[r] = a; }
#pragma unroll
            for (int r = 0; r < 16; ++r) { float a = ss[r]; a += __shfl_xor(a, 1); a += __shfl_xor(a, 2); a += __shfl_xor(a, 4); a += __shfl_xor(a, 8); a += __shfl_xor(a, 16);
                ss[r] = __builtin_amdgcn_rsqf(a * (1.0f / 256.0f) + 1e-6f) * 0.8f; }
            float gv[8];
            int go = r32; asm volatile("" : "+v"(go));
#pragma unroll
            for (int d = 0; d < 8; ++d) gv[d] = gout[go + d * 32];
            bf16* ob = merged + (size_t)(U.orow0 + rg * 32) * 2048 + U.h * 256;
            int oo = (4 * hi) * 2048 + r32; asm volatile("" : "+v"(oo));
#pragma unroll
            for (int r = 0; r < 16; ++r) { bf16* op = ob + (oo + ((r & 3) + 8 * (r >> 2)) * 2048);
#pragma unroll
                for (int d = 0; d < 8; ++d) op[d * 32] = (bf16)(cvtpk(o[d][r] * ss[r] * gv[d], 0.f) & 0xffffu); }
        }
        asm volatile("s_waitcnt lgkmcnt(0)" ::: "memory"); __builtin_amdgcn_s_barrier(); asm volatile("" ::: "memory");
    } else {
        if (active) {
            float ss[16];
#pragma unroll
            for (int r = 0; r < 16; ++r) { float a = 0.f;
#pragma unroll
                for (int d = 0; d < 4; ++d) { const float v = o[d][r] * rli[r]; o[d][r] = v; a += v * v; }
                ss[r] = a; }
#pragma unroll
            for (int r = 0; r < 16; ++r) { float a = ss[r]; a += __shfl_xor(a, 1); a += __shfl_xor(a, 2); a += __shfl_xor(a, 4); a += __shfl_xor(a, 8); a += __shfl_xor(a, 16);
                ss[r] = __builtin_amdgcn_rsqf(a * (1.0f / 128.0f) + 1e-6f); }
            float gv[4];
            int go = r32; asm volatile("" : "+v"(go));
#pragma unroll
            for (int d = 0; d < 4; ++d) gv[d] = gout[go + d * 32];
            bf16* ob = merged + (size_t)(U.orow0 + rg * 32) * 2048 + 1024 + U.h * 128;
            int oo = (4 * hi) * 2048 + r32; asm volatile("" : "+v"(oo));
#pragma unroll
            for (int r = 0; r < 16; ++r) { bf16* op = ob + (oo + ((r & 3) + 8 * (r >> 2)) * 2048);
#pragma unroll
                for (int d = 0; d < 4; ++d) op[d * 32] = (bf16)(cvtpk(o[d][r] * ss[r] * gv[d], 0.f) & 0xffffu); }
        }
    }
}


typedef float f32x4a __attribute__((ext_vector_type(4)));
__device__ __forceinline__ float xr16_max(float v) { auto r = __builtin_amdgcn_permlane16_swap(__float_as_uint(v), __float_as_uint(v), false, false); v = fmaxf(__uint_as_float(r[0]), __uint_as_float(r[1]));
    auto q = __builtin_amdgcn_permlane32_swap(__float_as_uint(v), __float_as_uint(v), false, false); return fmaxf(__uint_as_float(q[0]), __uint_as_float(q[1])); }
__device__ __forceinline__ float xr16_sum(float v) { auto r = __builtin_amdgcn_permlane16_swap(__float_as_uint(v), __float_as_uint(v), false, false); v = __uint_as_float(r[0]) + __uint_as_float(r[1]);
    auto q = __builtin_amdgcn_permlane32_swap(__float_as_uint(v), __float_as_uint(v), false, false); return __uint_as_float(q[0]) + __uint_as_float(q[1]); }
template <int I> struct Qk16 {
    static __device__ __forceinline__ void run(f32x4a (&sc)[2][4], const bf16x8 (&qf)[2][4], const int (&ka)[4], bf16x8 cur) {
        bf16x8 nxt;
        if constexpr (I < 15) { nxt = lds_rd128<((I + 1) & 3) * 4096>(ka[(I + 1) >> 2]); asm volatile("s_waitcnt lgkmcnt(1)" ::: "memory"); }
        else { asm volatile("s_waitcnt lgkmcnt(0)" ::: "memory"); }
        ASBAR();
        constexpr int ks = I >> 2, t = I & 3;
        sc[0][t] = __builtin_amdgcn_mfma_f32_16x16x32_bf16(cur, qf[0][ks], sc[0][t], 0, 0, 0);
        sc[1][t] = __builtin_amdgcn_mfma_f32_16x16x32_bf16(cur, qf[1][ks], sc[1][t], 0, 0, 0);
        ASBAR();
        if constexpr (I < 15) Qk16<I + 1>::run(sc, qf, ka, nxt);
    }
};
template <int DT> __device__ __forceinline__ void tr4(s16x4 (&f)[4], int vb) {
    constexpr int b = (DT >> 3) * 16384 + ((DT & 7) >> 1) * 512;
    f[0] = tr_read<b>(vb); f[1] = tr_read<b + 4096>(vb); f[2] = tr_read<b + 8192>(vb); f[3] = tr_read<b + 8192 + 4096>(vb);
}
template <int DT> struct Pv16 {
    static __device__ __forceinline__ void run(f32x4a (&o)[2][16], int ve, int vo, s16x4 (&cur)[4], const bf16x8 (&pb)[2][2]) {
        s16x4 nxt[4];
        if constexpr (DT < 15) { tr4<DT + 1>(nxt, ((DT + 1) & 1) ? vo : ve); asm volatile("s_waitcnt lgkmcnt(4)" ::: "memory"); }
        else { asm volatile("s_waitcnt lgkmcnt(0)" ::: "memory"); }
        ASBAR();
        const bf16x8 va0 = (bf16x8){cur[0][0], cur[0][1], cur[0][2], cur[0][3], cur[1][0], cur[1][1], cur[1][2], cur[1][3]};
        const bf16x8 va1 = (bf16x8){cur[2][0], cur[2][1], cur[2][2], cur[2][3], cur[3][0], cur[3][1], cur[3][2], cur[3][3]};
        o[0][DT] = __builtin_amdgcn_mfma_f32_16x16x32_bf16(va0, pb[0][0], o[0][DT], 0, 0, 0);
        o[1][DT] = __builtin_amdgcn_mfma_f32_16x16x32_bf16(va0, pb[1][0], o[1][DT], 0, 0, 0);
        o[0][DT] = __builtin_amdgcn_mfma_f32_16x16x32_bf16(va1, pb[0][1], o[0][DT], 0, 0, 0);
        o[1][DT] = __builtin_amdgcn_mfma_f32_16x16x32_bf16(va1, pb[1][1], o[1][DT], 0, 0, 0);
        ASBAR();
        if constexpr (DT < 15) Pv16<DT + 1>::run(o, ve, vo, nxt, pb);
    }
};

__device__ __forceinline__ void attn_unit_a16(ALAS unsigned char* lds, const UnitP U, const bf16* __restrict__ Qg, const bf16* __restrict__ Kg, const bf16* __restrict__ Vg,
                                              const float* __restrict__ gout, float lam, bf16* __restrict__ merged, const float* __restrict__ cacheK, const float* __restrict__ cacheV, int wid, int lane) {
    constexpr int NS = 2, STAGE = 65536;
    asm volatile("" : "+v"(lane));
    const int c = lane & 15, g = lane >> 4;
    const bool sample = U.kind >= 2;
    const int rg = wid & 3, map = wid >> 2;
    const bool active = sample ? (rg < 2) : true;
    const int wlast = sample ? 32 : (2 * U.qb + 1 + (rg >> 1)); const int lim0 = sample ? 63 : 15;
    const int qcol = U.h * 256 + map * 128, kcol = U.h * 256, vcol = kcol;
    unsigned kofs[2], vofs[2];
#pragma unroll
    for (int i = 0; i < 2; ++i) {
        const int pi = 64 * (wid + 8 * i) + lane;
        const int row = pi >> 4, ch = (pi & 15) ^ (row & 15); kofs[i] = (unsigned)(row * 1024 + ch * 8) * 2u;
        const int sub = pi >> 5, rem = pi & 31, kk = (sub >> 2) * 8 + (rem >> 2), cc = (sub & 3) * 32 + ((rem & 3) ^ (((sub >> 2) & 1) << 1)) * 8;
        const int k = (kk & ~0xC) | ((kk & 4) << 1) | ((kk & 8) >> 1); vofs[i] = (unsigned)(k * 1024 + cc) * 2u;
    }
    const float* ck = nullptr; const float* cv = nullptr; bf16* dk = nullptr; bf16* dv = nullptr;
    if (sample) {
        const int sidx = (int)((U.srow0 - 33024) / 2112);
        ck = cacheK + (size_t)sidx * 2048 * 1024 + kcol; cv = cacheV + (size_t)sidx * 2048 * 1024 + vcol;
        dk = (bf16*)Kg + (size_t)U.srow0 * 1024 + kcol; dv = (bf16*)Vg + (size_t)U.srow0 * 1024 + vcol;
        asm volatile("" : "+s"(ck), "+s"(cv), "+s"(dk), "+s"(dv));
        const int tid = wid * 64 + lane;
        conv_tile<32, 8>(ck, cv, dk, dv, 0, tid, 512);
        conv_tile<32, 8>(ck, cv, dk, dv, 1, tid, 512);
        asm volatile("s_waitcnt vmcnt(0)" ::: "memory"); __builtin_amdgcn_s_barrier();
        __builtin_amdgcn_fence(__ATOMIC_ACQUIRE, "agent"); asm volatile("s_waitcnt vmcnt(0)" ::: "memory");
    }
    const char* kbase = (const char*)Kg + ((size_t)U.srow0 * 1024 + kcol) * 2;
    const char* vbase = (const char*)Vg + ((size_t)U.srow0 * 1024 + vcol) * 2;
#define A16_ISSUE(j, s) do { const size_t _to = (size_t)(j) * (64 * 1024 * 2); \
        _Pragma("unroll") for (int _ks = 0; _ks < NS; ++_ks) _Pragma("unroll") for (int _i = 0; _i < 2; ++_i) \
            __builtin_amdgcn_global_load_lds((const unsigned*)(kbase + _to + _ks * 256 + kofs[_i]), (ALAS unsigned*)(lds + (s) * STAGE + _ks * 16384 + (wid + 8 * _i) * 1024), 16, 0, 0); \
        _Pragma("unroll") for (int _vs = 0; _vs < NS; ++_vs) _Pragma("unroll") for (int _i = 0; _i < 2; ++_i) \
            __builtin_amdgcn_global_load_lds((const unsigned*)(vbase + _to + _vs * 256 + vofs[_i]), (ALAS unsigned*)(lds + (s) * STAGE + (NS + _vs) * 16384 + (wid + 8 * _i) * 1024), 16, 0, 0); } while (0)
    if (sample && !active) {
        const int ct = ((wid >> 2) * 2 + (wid & 3) - 2) * 64 + lane;
        A16_ISSUE(0, 0);
        for (int j = 0; j < U.ntiles; ++j) {
            const int s = j & 1;
            asm volatile("s_waitcnt vmcnt(0)" ::: "memory"); __builtin_amdgcn_s_barrier(); asm volatile("" ::: "memory");
            if (j + 1 < U.ntiles) A16_ISSUE(j + 1, s ^ 1);
            asm volatile("" : "+s"(ck), "+s"(cv), "+s"(dk), "+s"(dv));
            if (j + 2 < 32) { conv_tile<32, 8>(ck, cv, dk, dv, j + 2, ct, 512); conv_tile<32, 8>(ck, cv, dk, dv, j + 2, ct + 256, 512); }
        }
        asm volatile("s_waitcnt vmcnt(0) lgkmcnt(0)" ::: "memory");
        __builtin_amdgcn_s_barrier(); __builtin_amdgcn_s_barrier(); __builtin_amdgcn_s_barrier();
        return;
    }
    bf16x8 qf[2][4];
    if (active) {
#pragma unroll
        for (int a = 0; a < 2; ++a) { const bf16* Qw = Qg + (size_t)(U.orow0 + rg * 32 + 16 * a + c) * 1024 + qcol + 8 * g;
#pragma unroll
            for (int ks = 0; ks < 4; ++ks) qf[a][ks] = *(const bf16x8*)(Qw + 32 * ks); }
    } else {
#pragma unroll
        for (int a = 0; a < 2; ++a)
#pragma unroll
            for (int ks = 0; ks < 4; ++ks) qf[a][ks] = (bf16x8){0, 0, 0, 0, 0, 0, 0, 0};
    }
    float m_reg[2] = {-1e30f, -1e30f}, l_reg[2] = {0.f, 0.f};
    f32x4a o[2][16];
#pragma unroll
    for (int a = 0; a < 2; ++a)
#pragma unroll
        for (int d = 0; d < 16; ++d) o[a][d] = (f32x4a){0.f, 0.f, 0.f, 0.f};
    int kx[4];
#pragma unroll
    for (int ks = 0; ks < 4; ++ks) kx[ks] = c * 256 + ((64 * ks + 16 * g) ^ (c << 4));
    const int vbl = (int)(unsigned)(uintptr_t)(lds + NS * 16384) + (g & 1) * 2048 + (g >> 1) * 256 + (c >> 2) * 64;
    const int vbE = vbl + (((c & 3) * 8) ^ ((g & 1) << 5)), vbO = vbl + ((32 + (c & 3) * 8) ^ ((g & 1) << 5));

    A16_ISSUE(0, 0);
    for (int j = 0; j < U.ntiles; ++j) {
        const int s = j & 1;
        asm volatile("s_waitcnt vmcnt(0)" ::: "memory"); __builtin_amdgcn_s_barrier(); asm volatile("" ::: "memory");
        if (j + 1 < U.ntiles) A16_ISSUE(j + 1, s ^ 1);
        if (active && j <= wlast) {
            f32x4a sc[2][4];
#pragma unroll
            for (int a = 0; a < 2; ++a)
#pragma unroll
                for (int t = 0; t < 4; ++t) sc[a][t] = (f32x4a){0.f, 0.f, 0.f, 0.f};
            {
                const int Ks = (int)(unsigned)(uintptr_t)(lds + s * STAGE + map * 16384);
                int ka[4];
#pragma unroll
                for (int i = 0; i < 4; ++i) ka[i] = Ks + kx[i];
                bf16x8 k0 = lds_rd128<0>(ka[0]);
                Qk16<0>::run(sc, qf, ka, k0);
            }
            if (j == 0 && lim0 < 63) {
                const float NEG = -__builtin_inff();
#pragma unroll
                for (int a = 0; a < 2; ++a)
#pragma unroll
                    for (int t = 1; t < 4; ++t) sc[a][t] = (f32x4a){NEG, NEG, NEG, NEG};
            }
            float pm[2], al[2] = {1.f, 1.f}, mn[2];
#pragma unroll
            for (int a = 0; a < 2; ++a) { float v = sc[a][0][0];
#pragma unroll
                for (int t = 0; t < 4; ++t)
#pragma unroll
                    for (int r = 0; r < 4; ++r) v = fmaxf(v, sc[a][t][r]);
                pm[a] = xr16_max(v); }
            if (__all((pm[0] - m_reg[0] <= THR2) && (pm[1] - m_reg[1] <= THR2))) { mn[0] = m_reg[0]; mn[1] = m_reg[1]; }
            else {
#pragma unroll
                for (int a = 0; a < 2; ++a) { mn[a] = fmaxf(m_reg[a], pm[a]); al[a] = __builtin_amdgcn_exp2f(m_reg[a] - mn[a]); m_reg[a] = mn[a]; }
                if (__any(al[0] < 1.f || al[1] < 1.f)) {
#pragma unroll
                    for (int a = 0; a < 2; ++a)
#pragma unroll
                        for (int d = 0; d < 16; ++d) o[a][d] = o[a][d] * al[a];
                }
            }
            bf16x8 pb[2][2];
#pragma unroll
            for (int a = 0; a < 2; ++a) { float ps = 0.f;
#pragma unroll
                for (int t = 0; t < 4; ++t)
#pragma unroll
                    for (int r = 0; r < 4; ++r) { const float e = __builtin_amdgcn_exp2f(sc[a][t][r] - mn[a]); sc[a][t][r] = e; ps += e; }
                l_reg[a] = l_reg[a] * al[a] + xr16_sum(ps);
#pragma unroll
                for (int s2 = 0; s2 < 2; ++s2) { u32x4 w = {cvtpk(sc[a][2 * s2][0], sc[a][2 * s2][1]), cvtpk(sc[a][2 * s2][2], sc[a][2 * s2][3]), cvtpk(sc[a][2 * s2 + 1][0], sc[a][2 * s2 + 1][1]), cvtpk(sc[a][2 * s2 + 1][2], sc[a][2 * s2 + 1][3])};
                    pb[a][s2] = *reinterpret_cast<bf16x8*>(&w); } }
            { const int ve = vbE + s * STAGE, vo = vbO + s * STAGE; s16x4 f0[4]; tr4<0>(f0, ve); Pv16<0>::run(o, ve, vo, f0, pb); }
        }
    }
#undef A16_ISSUE
    asm volatile("s_waitcnt lgkmcnt(0)" ::: "memory"); __builtin_amdgcn_s_barrier(); asm volatile("" ::: "memory");
    ALAS float* X = (ALAS float*)lds + (size_t)rg * (32 * 256);
    int xo = c * 256 + 4 * g; asm volatile("" : "+v"(xo));
    if (active && map == 1) {
#pragma unroll
        for (int a = 0; a < 2; ++a) { const float rl = __builtin_amdgcn_rcpf(l_reg[a]);
#pragma unroll
            for (int d = 0; d < 16; ++d) *(ALAS f32x4a*)(X + xo + a * 16 * 256 + d * 16) = o[a][d] * rl; }
    }
    asm volatile("s_waitcnt lgkmcnt(0)" ::: "memory"); __builtin_amdgcn_s_barrier(); asm volatile("" ::: "memory");
    if (active && map == 0) {
        int go = 4 * g; asm volatile("" : "+v"(go));
        bf16* ob = merged + (size_t)(U.orow0 + rg * 32) * 2048 + U.h * 256;
        int oo = c * 2048 + 4 * g; asm volatile("" : "+v"(oo));
#pragma unroll
        for (int a = 0; a < 2; ++a) { const float rl = __builtin_amdgcn_rcpf(l_reg[a]); float ss = 0.f;
#pragma unroll
            for (int d = 0; d < 16; ++d) { const f32x4a x2 = *(const ALAS f32x4a*)(X + xo + a * 16 * 256 + d * 16); const f32x4a v = o[a][d] * rl - x2 * lam; o[a][d] = v;
                ss += (v[0] * v[0] + v[1] * v[1]) + (v[2] * v[2] + v[3] * v[3]); }
            const float rs = __builtin_amdgcn_rsqf(xr16_sum(ss) * (1.0f / 256.0f) + 1e-6f) * 0.8f;
#pragma unroll
            for (int d = 0; d < 16; ++d) { const f32x4a gv = *(const f32x4a*)(gout + go + d * 16); const f32x4a v = o[a][d] * rs * gv;
                typedef unsigned u32x2a __attribute__((ext_vector_type(2)));
                u32x2a w; w.x = cvtpk(v[0], v[1]); w.y = cvtpk(v[2], v[3]);
                *(u32x2a*)(ob + oo + a * 16 * 2048 + d * 16) = w; } }
    }
    asm volatile("s_waitcnt lgkmcnt(0)" ::: "memory"); __builtin_amdgcn_s_barrier(); asm volatile("" ::: "memory");
}

constexpr int N_Q_UNITS = 94 + 16 + 16 + 32 + 18 + 128;
__device__ __forceinline__ bool decode_unit(int q, int w, UnitP& U) {
    auto Ap = [&](int L, int bh) { U.kind = 0; U.qb = L; const int b = bh >> 2; U.h = bh & 3; U.orow0 = (long)b * 8192 + 128 * L; U.srow0 = (long)b * 8256; U.ntiles = 2 * L + 3; };
    auto Bp = [&](int L, int bh) { U.kind = 1; U.qb = L; const int b = bh >> 3; U.h = bh & 7; U.orow0 = (long)b * 8192 + 256 * L; U.srow0 = (long)b * 8256; U.ntiles = 4 * L + 5; };
    auto As = [&](int i) { U.kind = 2; U.qb = 0; const int s = i >> 2; U.h = i & 3; U.orow0 = 32768 + 64 * s; U.srow0 = 33024 + (long)s * 2112; U.ntiles = 33; };
    auto Bs = [&](int i) { U.kind = 3; U.qb = 0; const int s = i >> 3; U.h = i & 7; U.orow0 = 32768 + 64 * s; U.srow0 = 33024 + (long)s * 2112; U.ntiles = 33; };
    if (w < 94) { Ap(63 - (w >> 1), 2 * q + (w & 1)); return true; } w -= 94;
    if (w < 16) { As(16 * q + w); return true; } w -= 16;
    if (w < 16) { Ap(16 - (w >> 1), 2 * q + (w & 1)); return true; } w -= 16;
    if (w < 32) { Bs(32 * q + w); return true; } w -= 32;
    if (w < 18) { Ap(8 - (w >> 1), 2 * q + (w & 1)); return true; } w -= 18;
    if (w < 128) { Bp(31 - (w >> 2), 4 * q + (w & 3)); return true; }
    return false;
}
}

constexpr int DM = 2048, FF = 5632, NIN = 6152, NQKV = 6144;
constexpr int MA = 34816;
constexpr int M1 = 35072;
constexpr int SEQP = 8208, PSTR = 8256, SSTR = 2112, SROW_S0 = 4 * PSTR, NSR = SROW_S0 + 32 * SSTR;
constexpr size_t O_YP = 0, O_YS = O_YP + (size_t)4 * 8192 * 2048, O_AKP = O_YS + (size_t)32 * 64 * 2048, O_AVP = O_AKP + (size_t)4 * SEQP * 1024, O_BKP = O_AVP + (size_t)4 * SEQP * 1024,
                 O_BVP = O_BKP + (size_t)4 * SEQP * 1024, O_LFP = O_BVP + (size_t)4 * SEQP * 1024, O_AKS = O_LFP + (size_t)4 * SEQP * 8, O_AVS = O_AKS + (size_t)2048 * 1024,
                 O_BKS = O_AVS + (size_t)2048 * 1024, O_BVS = O_BKS + (size_t)2048 * 1024, O_LFS = O_BVS + (size_t)2048 * 1024, O_END = O_LFS + (size_t)2048 * 8;
constexpr size_t MiB = 1u << 20;
constexpr size_t WS_CTL = 0, CTL_ZERO_BYTES = 1 * MiB;
constexpr size_t WS_W13A = 1 * MiB, WS_W13B = WS_W13A + 44 * MiB, WS_W2A = WS_W13B + 44 * MiB, WS_W2B = WS_W2A + 22 * MiB, WS_WIN = WS_W2B + 22 * MiB, WS_WO = WS_WIN + 24 * MiB;
constexpr size_t WS_WF = WS_WO + 8 * MiB, WS_ROPE = WS_WF + 1 * MiB, WS_CT = WS_ROPE + 2 * MiB, WS_RESID = WS_CT + 4 * MiB;
constexpr size_t WS_XN = WS_RESID + 274 * MiB, WS_QA = WS_XN + 137 * MiB, WS_QB = WS_QA + 68 * MiB, WS_KA = WS_QB + 68 * MiB;
constexpr size_t SBUF = (size_t)NSR * 1024 * 2;
constexpr size_t WS_VA = WS_KA + SBUF, WS_KB = WS_VA + SBUF, WS_VB = WS_KB + SBUF, WS_END = WS_VB + SBUF;
constexpr size_t WS_SLAB = WS_KB + 66 * MiB;
constexpr size_t WS_H = WS_QA;
static_assert((size_t)M1 * DM * 4 <= 274 * MiB && (size_t)M1 * DM * 2 <= 137 * MiB && (size_t)MA * 1024 * 2 <= 68 * MiB && WS_H + (size_t)M1 * FF * 2 <= WS_END, "d_ws map");
static_assert((size_t)8208 * 32 * 4 <= 2 * MiB && (size_t)8 * NSR * 4 <= 4 * MiB, "d_ws map");
constexpr int CW_TMO = 0, CW_QUEUE = 1024, CW_LAM = 128, CW_PRUNE = 136, CW_SBA = 144, CW_CQ0 = 2048, CW_CQ1 = 2112, CW_CQ2 = 2176, CW_XRANK = 2560, CW_DYN = 3072, CW_BAR = 4096;
constexpr int LDS_RING = 0, LDS_CTL = 131072, LDS_SCR = 131072 + 256, LDS_BYTES = 131072 + 256 + 8192 + 2048 + 256;
static_assert(att::A_WS == LDS_SCR && att::A_QW == LDS_CTL + 16, "LDS map");

#define GAS __attribute__((address_space(1)))
#define LAS __attribute__((address_space(3)))
typedef unsigned short bf16;
typedef unsigned v4u __attribute__((ext_vector_type(4)));
typedef unsigned v2u __attribute__((ext_vector_type(2)));
typedef float f32x4 __attribute__((ext_vector_type(4)));
#define RLX_AGENT __ATOMIC_RELAXED, __HIP_MEMORY_SCOPE_AGENT
#define LDS_WAIT() asm volatile("s_waitcnt lgkmcnt(0)" ::: "memory")
__device__ __forceinline__ unsigned f2bf(float f) { unsigned u = __builtin_bit_cast(unsigned, f); return (u + 0x7fffu + ((u >> 16) & 1u)) >> 16; }
__device__ __forceinline__ unsigned pk2(float lo, float hi) { return f2bf(lo) | (f2bf(hi) << 16); }
__device__ __forceinline__ float wave_sum(float v) {
#pragma unroll
    for (int o = 1; o < 64; o <<= 1) v += __shfl_xor(v, o);
    return v;
}
#define XB_TMO      128
#define XB_XCNT(j)  (256  + 64 * (j))
#define XB_XSUB(j)  (1280 + 64 * (j))
#define XB_XGEN(j)  (2304 + 64 * (j))
#define XB_TOP      3328
#define XB_TOPGEN   3392
#define XCD_BAR_WORDS 3456
#define XB_SPIN_CAP (1u << 18)

__device__ __forceinline__ unsigned xb_ld(unsigned* p)              { return __hip_atomic_load(p, __ATOMIC_RELAXED, __HIP_MEMORY_SCOPE_AGENT); }
__device__ __forceinline__ unsigned xb_add(unsigned* p, unsigned v) { return __hip_atomic_fetch_add(p, v, __ATOMIC_RELAXED, __HIP_MEMORY_SCOPE_AGENT); }
__device__ __forceinline__ unsigned xb_xcc_id() { return (unsigned)__builtin_amdgcn_s_getreg((3 << 11) | 20) & 0xFu; }
#define XB_SPIN(cond, bar) do { unsigned _sp = 0; while (cond) { __builtin_amdgcn_s_sleep(1); \
    if ((++_sp & 255u) == 0u) { if (xb_ld(&(bar)[XB_TMO])) break; if (_sp > XB_SPIN_CAP) { atomicAdd(&(bar)[XB_TMO], 1u); break; } } } } while (0)

struct XcdBarrier {
    unsigned* bar; unsigned x;
    volatile LAS unsigned* st;
};

__device__ __forceinline__ XcdBarrier xcd_barrier_post(unsigned* bar, volatile LAS unsigned* st) {
    XcdBarrier b; b.bar = bar; b.x = xb_xcc_id(); b.st = st;
    if (threadIdx.x == 0) (void)xb_add(&bar[XB_XCNT(b.x)], 1u);
    return b;
}
__device__ __forceinline__ void xcd_barrier_complete(unsigned* bar, unsigned x, unsigned& nloc, unsigned& nx) {
    const unsigned G = gridDim.x * gridDim.y * gridDim.z;
    unsigned sum, cnt, mine, sp = 0u;
    for (;;) {
        sum = 0u; cnt = 0u; mine = 0u;
#pragma unroll
        for (unsigned j = 0; j < 16; ++j) { const unsigned c = xb_ld(&bar[XB_XCNT(j)]); sum += c; cnt += (c > 0u) ? 1u : 0u; mine = (j == x) ? c : mine; }
        if (sum == G) break;
        __builtin_amdgcn_s_sleep(1);
        if ((++sp & 255u) == 0u) { if (xb_ld(&bar[XB_TMO])) break; if (sp > XB_SPIN_CAP) { atomicAdd(&bar[XB_TMO], 1u); break; } }
    }
    nloc = mine > 0u ? mine : 1u; nx = cnt > 0u ? cnt : 1u;
}

__device__ __forceinline__ void xcd_barrier(const XcdBarrier& b) {
    asm volatile("s_waitcnt vmcnt(0)" ::: "memory");
    __syncthreads();
    if (threadIdx.x == 0) {
        unsigned* bar = b.bar;
        __builtin_amdgcn_s_waitcnt(0);
        unsigned nloc = b.st[0], nx = b.st[1];
        if (nloc == 0u) { xcd_barrier_complete(bar, b.x, nloc, nx); b.st[0] = nloc; b.st[1] = nx; }
        const unsigned old = xb_add(&bar[XB_XSUB(b.x)], 1u);
        const unsigned gen = old / nloc;
        if (old + 1u == (gen + 1u) * nloc) {
            __builtin_amdgcn_fence(__ATOMIC_RELEASE, "agent");
            asm volatile("s_waitcnt vmcnt(0)" ::: "memory");
            const unsigned og = xb_add(&bar[XB_TOP], 1u);
            const unsigned tg = og / nx;
            if (og + 1u == (tg + 1u) * nx) xb_add(&bar[XB_TOPGEN], 1u);
            else XB_SPIN(xb_ld(&bar[XB_TOPGEN]) == tg, bar);
            __builtin_amdgcn_fence(__ATOMIC_ACQUIRE, "agent");
            xb_add(&bar[XB_XGEN(b.x)], 1u);
            asm volatile("s_waitcnt vmcnt(0)" ::: "memory");
        } else {
            XB_SPIN(xb_ld(&bar[XB_XGEN(b.x)]) == gen, bar);
            __builtin_amdgcn_fence(__ATOMIC_ACQUIRE, "agent");
            asm volatile("s_waitcnt vmcnt(0)" ::: "memory");
        }
    }
    __syncthreads();
}

struct Args { const float* in[31]; float* out; unsigned char* ws; int ph_lo, ph_hi, li, pad; };
constexpr int N_PHASES = 11;
enum { I_XP = 0, I_XS, I_CAK, I_CAV, I_CBK, I_CBV, I_CLF, I_META, I_GF1, I_F1W1, I_F1W3, I_F1W2, I_GMIX, I_WIN, I_BF, I_GQA, I_GKA, I_GQB, I_GKB, I_LQ1, I_LK1, I_LQ2, I_LK2, I_GOA, I_GOB, I_WOUT, I_GF2, I_F2W1, I_F2W3, I_F2W2, I_GFIN };

__device__ __forceinline__ void transpose_item(const float* W, int ldw, int K, bf16* WT, int k0, int n0, int out_row0, LAS float* scr, int lane) {
#pragma unroll 8
    for (int i = 0; i < 32; ++i) { const int kk = 2 * i + (lane >> 5); scr[kk * 33 + (lane & 31)] = W[(size_t)(k0 + kk) * ldw + n0 + (lane & 31)]; }
    LDS_WAIT(); asm volatile("" ::: "memory");
    const int c = lane & 7;
#pragma unroll
    for (int j = 0; j < 4; ++j) { const int n = (lane >> 3) + 8 * j; const LAS float* s = scr + (8 * c) * 33 + n;
        v4u o; o.x = pk2(s[0 * 33], s[1 * 33]); o.y = pk2(s[2 * 33], s[3 * 33]); o.z = pk2(s[4 * 33], s[5 * 33]); o.w = pk2(s[6 * 33], s[7 * 33]);
        *(GAS v4u*)(WT + (size_t)(out_row0 + n) * K + k0 + 8 * c) = o; }
    LDS_WAIT(); asm volatile("" ::: "memory");
}
__device__ __forceinline__ float rms_load(const float* xrow, int lane, f32x4 (&v)[8]) {
    const GAS f32x4* xr = (const GAS f32x4*)xrow + lane; float s = 0.f;
#pragma unroll
    for (int j = 0; j < 8; ++j) { v[j] = xr[64 * j]; s += (v[j].x * v[j].x + v[j].y * v[j].y) + (v[j].z * v[j].z + v[j].w * v[j].w); }
    return __builtin_amdgcn_rsqf(wave_sum(s) * (1.0f / 2048.0f) + 1e-6f);
}
__device__ __forceinline__ void store_row_bf16(bf16* orow, int lane, const f32x4 (&v)[8]) {
    GAS v2u* o8 = (GAS v2u*)orow + lane;
#pragma unroll
    for (int j = 0; j < 8; ++j) { v2u w; w.x = pk2(v[j].x, v[j].y); w.y = pk2(v[j].z, v[j].w); o8[64 * j] = w; }
}
__device__ __forceinline__ const float* in_row(const Args& a, int R) {
    return (R < 32768) ? a.in[I_XP] + (size_t)R * DM : (R < 34816) ? a.in[I_XS] + (size_t)(R - 32768) * DM : (R < 34832) ? a.in[I_META] + (size_t)(R - 34816) * DM : nullptr;
}

__device__ __forceinline__ void build_tail_table(LAS unsigned short* tab, int M, int G, int tid) {
    pg8::TailOrder T; T.init(M, DM, G, 0, 1, 0);
    for (int i = tid; i < (M / 256) * 8; i += 512) tab[i] = 0;
    __syncthreads();
    for (int t = tid; t < T.nitems; t += 512) { pg8::Unit u; T.S.decode(T.base + t, u); tab[u.pm * 8 + u.pn] = (unsigned short)(t + 1); }
    __syncthreads();
}
template <int MODE>
__device__ __forceinline__ bool tail_fix(f32x4 (&v)[8], const LAS unsigned short* tab, const float* slabs, int R, int lane, float alpha, const float* xin) {
    const v4u tq = *(const LAS v4u*)(tab + (R >> 8) * 8);
    if ((tq.x | tq.y | tq.z | tq.w) == 0u) return false;
    const unsigned tw[4] = {tq.x, tq.y, tq.z, tq.w};
#pragma unroll
    for (int j = 0; j < 8; ++j) {
        const unsigned slot = (tw[j >> 1] >> (16 * (j & 1))) & 0xffffu;
        if (slot) {
            const GAS f32x4* sp = (const GAS f32x4*)(slabs + (size_t)(slot - 1) * 4 * 65536 + (size_t)(R & 255) * 256) + lane;
            const f32x4 s = (sp[0] + sp[16384]) + (sp[2 * 16384] + sp[3 * 16384]);
            f32x4 b = v[j];
            if (MODE == 1) b = xin ? ((const GAS f32x4*)xin)[64 * j + lane] : (f32x4){0.f, 0.f, 0.f, 0.f};
            v[j] = b + s * alpha;
        }
    }
    return true;
}
__device__ __forceinline__ void row_load(const float* xrow, int lane, f32x4 (&v)[8]) {
    const GAS f32x4* xr = (const GAS f32x4*)xrow + lane;
#pragma unroll
    for (int j = 0; j < 8; ++j) v[j] = xr[64 * j];
}
__device__ __forceinline__ void row_store(float* xrow, int lane, const f32x4 (&v)[8]) {
    GAS f32x4* xr = (GAS f32x4*)xrow + lane;
#pragma unroll
    for (int j = 0; j < 8; ++j) xr[64 * j] = v[j];
}
__device__ __forceinline__ float row_rstd(const f32x4 (&v)[8]) {
    float s = 0.f;
#pragma unroll
    for (int j = 0; j < 8; ++j) s += (v[j].x * v[j].x + v[j].y * v[j].y) + (v[j].z * v[j].z + v[j].w * v[j].w);
    return __builtin_amdgcn_rsqf(wave_sum(s) * (1.0f / 2048.0f) + 1e-6f);
}
constexpr int CV_I13 = 32 * 176, CV_I2 = 88 * 64, CV_IIN = 32 * 192, CV_IO = 32 * 64, CV_N = 4 * CV_I13 + 2 * CV_I2 + CV_IIN + CV_IO;
#define CONV_ITEM(itx) do { int r_ = (itx); LAS float* scr_ = (LAS float*)(lds + LDS_RING + wid * 16384); \
        if (r_ < 4 * CV_I13) { const int which = r_ / CV_I13; r_ -= which * CV_I13; const int kb = r_ / 176, nb = r_ % 176, n0 = 32 * nb; \
            const float* W = (const float*)(const GAS float*)a.in[which == 0 ? I_F1W1 : which == 1 ? I_F1W3 : which == 2 ? I_F2W1 : I_F2W3]; \
            transpose_item(W, FF, DM, (which < 2) ? W13A : W13B, 64 * kb, n0, (n0 >> 7) * 256 + (n0 & 127) + (which & 1) * 128, scr_, lane); break; } \
        r_ -= 4 * CV_I13; \
        if (r_ < 2 * CV_I2) { const int which = r_ / CV_I2; r_ -= which * CV_I2; const int kb = r_ / 64, nb = r_ % 64; \
            transpose_item((const float*)(const GAS float*)a.in[which ? I_F2W2 : I_F1W2], DM, FF, which ? W2B : W2A, 64 * kb, 32 * nb, 32 * nb, scr_, lane); break; } \
        r_ -= 2 * CV_I2; \
        if (r_ < CV_IIN) { const int kb = r_ / 192, nb = r_ % 192; transpose_item(INP(I_WIN), NIN, DM, WINT, 64 * kb, 32 * nb, 32 * nb, scr_, lane); break; } \
        r_ -= CV_IIN; \
        { const int kb = r_ / 64, nb = r_ % 64; transpose_item(INP(I_WOUT), DM, DM, WOT, 64 * kb, 32 * nb, 32 * nb, scr_, lane); } } while (0)
#define CONV_QUEUE(cw, lo, hi) do { for (;;) { unsigned q_ = 0; if (lane == 0) q_ = __hip_atomic_fetch_add(ctl + (cw), 4u, RLX_AGENT); \
        const int i0_ = (lo) + (int)__builtin_amdgcn_readfirstlane(q_); if (i0_ >= (hi)) break; \
        for (int k_ = 0; k_ < 4; ++k_) if (i0_ + k_ < (hi)) { CONV_ITEM(i0_ + k_); } } } while (0)
#define PH_PTRS \
    GAS unsigned char* ws_g = (GAS unsigned char*)a.ws; asm volatile("" : "+s"(ws_g)); unsigned char* ws = (unsigned char*)ws_g; \
    GAS float* out_g = (GAS float*)a.out; asm volatile("" : "+s"(out_g)); float* out = (float*)out_g;     \
    unsigned* ctl = (unsigned*)(ws + WS_CTL); (void)ctl; (void)out; \
    bf16* W13A = (bf16*)(ws + WS_W13A); bf16* W13B = (bf16*)(ws + WS_W13B); bf16* W2A = (bf16*)(ws + WS_W2A); bf16* W2B = (bf16*)(ws + WS_W2B); \
    bf16* WINT = (bf16*)(ws + WS_WIN); bf16* WOT = (bf16*)(ws + WS_WO); \
    float* GAINS = (float*)(ws + WS_WF + 512 * 1024); float* WF = (float*)(ws + WS_WF); float* ROPE = (float*)(ws + WS_ROPE); float* CT = (float*)(ws + WS_CT); float* RESID = (float*)(ws + WS_RESID); \
    bf16* XN = (bf16*)(ws + WS_XN); bf16* QA = (bf16*)(ws + WS_QA); bf16* QB = (bf16*)(ws + WS_QB); \
    bf16* KA = (bf16*)(ws + WS_KA); bf16* VA = (bf16*)(ws + WS_VA); bf16* KB = (bf16*)(ws + WS_KB); bf16* VB = (bf16*)(ws + WS_VB); bf16* HB = (bf16*)(ws + WS_H); float* SLABS = (float*)(ws + WS_SLAB); (void)SLABS; \
    (void)W13A; (void)W13B; (void)W2A; (void)W2B; (void)WINT; (void)WOT; (void)GAINS; (void)WF; (void)ROPE; (void)CT; (void)RESID; (void)XN; (void)QA; (void)QB; (void)KA; (void)VA; (void)KB; (void)VB; (void)HB
__device__ __forceinline__ int opq(int k) { asm volatile("" : "+s"(k)); return k; }
#define INP(k) ((const float*)(const GAS float*)a.in[opq(k)])
__global__ void __launch_bounds__(512, 2) fwd(Args a) {
    extern __shared__ __attribute__((aligned(16))) unsigned char lds_raw[];
    LAS unsigned char* lds = (LAS unsigned char*)lds_raw;
    const int tid = threadIdx.x, lane = tid & 63, wid = __builtin_amdgcn_readfirstlane(tid >> 6);
    const int G = gridDim.x, bx = blockIdx.x;
    const int gw = bx * 8 + wid, NGW = G * 8;
    unsigned* ctl0 = (unsigned*)(a.ws + WS_CTL);
    for (int u = tid; u < (LDS_BYTES - LDS_CTL) / 4; u += 512) ((LAS unsigned*)(lds + LDS_CTL))[u] = 0u;
    __syncthreads();
    const int lo = a.ph_lo, hi = a.ph_hi;
    XcdBarrier bar; bar.bar = ctl0 + CW_BAR + a.li * XCD_BAR_WORDS; bar.x = 0; bar.st = nullptr;
    if (hi - lo > 1) bar = xcd_barrier_post(ctl0 + CW_BAR + a.li * XCD_BAR_WORDS, (volatile LAS unsigned*)(lds + LDS_CTL));
#ifndef MK_SPLITK
#define MK_SPLITK 0
#endif
#ifndef MK_ATT_A
#define MK_ATT_A 1
#endif
#ifndef MK_ATT_B
#define MK_ATT_B 1
#endif
#ifndef MK_PHASE_MASK
#define MK_PHASE_MASK 0x7ff
#endif
#define IN(k) ((((MK_PHASE_MASK) >> (k)) & 1) && lo <= (k) && (k) < hi)
#define SEAM(k) do { if (IN(k) && IN((k) + 1)) xcd_barrier(bar); } while (0)

    if (IN(0)) {
        PH_PTRS;
#ifndef MK_P0_REP
#define MK_P0_REP 1
#endif
        for (int rep0 = 0; rep0 < MK_P0_REP; ++rep0) {
        LAS float* scr = (LAS float*)(lds + LDS_RING + wid * 16384);
        for (int it = gw; it < 2 * CV_I13; it += NGW) { CONV_ITEM(it); }
        for (int i = bx * 512 + tid; i < 512; i += G * 512) GAINS[i] = a.in[I_GQA + (i >> 7)][i & 127];
        for (int i = bx * 512 + tid; i < DM * 8; i += G * 512) WF[i] = INP(I_WIN)[(size_t)(i >> 3) * NIN + NQKV + (i & 7)];
        if (bx == 0 && wid == 0) {
            const float* q1 = INP(I_LQ1); const float* k1 = INP(I_LK1); const float* q2 = INP(I_LQ2); const float* k2 = INP(I_LK2);
            const float s1 = wave_sum(q1[lane] * k1[lane] + q1[lane + 64] * k1[lane + 64]), s2 = wave_sum(q2[lane] * k2[lane] + q2[lane + 64] * k2[lane + 64]);
            if (lane == 0) ((float*)ctl)[CW_LAM] = expf(s1) - expf(s2) + 0.2f;
            float gq = fmaxf(fabsf(INP(I_GQB)[lane]), fabsf(INP(I_GQB)[lane + 64])), gk = fmaxf(fabsf(INP(I_GKB)[lane]), fabsf(INP(I_GKB)[lane + 64]));
#pragma unroll
            for (int o = 1; o < 64; o <<= 1) { gq = fmaxf(gq, __shfl_xor(gq, o)); gk = fmaxf(gk, __shfl_xor(gk, o)); }
            if (lane == 0) ((float*)ctl)[CW_PRUNE] = 2.0f * 16.5f * gq * gk + 40.0f;
        }
        const float* xp_ = INP(I_XP); const float* xs_ = INP(I_XS); const float* mt_ = INP(I_META);
        for (int R = gw; R < M1; R += NGW) {
            const float* xr = (R < 32768) ? xp_ + (size_t)R * DM : (R < 34816) ? xs_ + (size_t)(R - 32768) * DM : (R < 34832) ? mt_ + (size_t)(R - 34816) * DM : nullptr; f32x4 v[8];
            if (xr) { const float rs = rms_load(xr, lane, v); const GAS f32x4* g = (const GAS f32x4*)INP(I_GF1) + lane;
#pragma unroll
                for (int j = 0; j < 8; ++j) v[j] = v[j] * rs * g[64 * j]; }
            else {
#pragma unroll
                for (int j = 0; j < 8; ++j) v[j] = (f32x4){0.f, 0.f, 0.f, 0.f}; }
            store_row_bf16(XN + (size_t)R * DM, lane, v);
        }
        }
    }
    SEAM(0);
    if (IN(1)) {
        PH_PTRS;
#ifndef MK_P1_REP
#define MK_P1_REP 1
#endif
        for (int rep = 0; rep < MK_P1_REP; ++rep) {
        pg8::Gemm g{XN, W13A, M1, 2 * FF, DM, DM}; pg8::StaticOrder S; S.init(M1, 2 * FF, G, bx);
        pg8::EpiSwiGLU E{HB, FF};
        pg8::gemm_phase<pg8::EpiSwiGLU, pg8::StaticOrder, true, true>(lds + LDS_RING, g, S, E);
        }
        CONV_QUEUE(CW_CQ0, 4 * CV_I13, 4 * CV_I13 + CV_I2);
    }
    SEAM(1);
    if (IN(2)) {
        PH_PTRS;
        pg8::Gemm g{HB, W2A, M1, DM, FF, FF}; pg8::StaticOrder S; S.init(M1, DM, G, bx); if (MK_SPLITK) S.nr = S.nwg / G;
        pg8::EpiResid<1> E{RESID, INP(I_XP), INP(I_XS), INP(I_META), 0.5f};
        pg8::gemm_phase<pg8::EpiResid<1>, pg8::StaticOrder, true, true>(lds + LDS_RING, g, S, E);
        pg8::Gemm g4{HB, W2A, M1, DM, FF / 4, FF}; pg8::TailOrder T; T.init(M1, DM, G, bx, 4, FF / 4);
        pg8::EpiSlab EA{SLABS};
        if (MK_SPLITK) pg8::gemm_phase<pg8::EpiSlab, pg8::TailOrder, true, true>(lds + LDS_RING, g4, T, EA);
        CONV_QUEUE(CW_CQ1, 2 * CV_I13, 4 * CV_I13);
        CONV_QUEUE(CW_CQ2, 4 * CV_I13 + CV_I2, CV_N);
    }
    SEAM(2);
    if (IN(3)) {
        PH_PTRS;
#ifndef MK_P3_REP
#define MK_P3_REP 1
#endif
        for (int rep3 = 0; rep3 < MK_P3_REP; ++rep3) {
        {
            LAS float* wft = (LAS float*)(lds + LDS_RING);
            for (int i = tid; i < DM * 8; i += 512) wft[(i & 7) * DM + (i >> 3)] = WF[i];
            __syncthreads();
        }
        LAS unsigned short* ttab = (LAS unsigned short*)(lds + LDS_SCR);
        if (MK_SPLITK) build_tail_table(ttab, M1, G, tid);
        const float* xp_ = INP(I_XP); const float* xs_ = INP(I_XS); const float* mt_ = INP(I_META);
        for (int R = gw; R < 34832; R += NGW) {
            f32x4 v[8]; row_load(RESID + (size_t)R * DM, lane, v);
            if (MK_SPLITK) { const float* xin = (R < 32768) ? xp_ + (size_t)R * DM : (R < 34816) ? xs_ + (size_t)(R - 32768) * DM : mt_ + (size_t)(R - 34816) * DM;
                if (tail_fix<1>(v, ttab, SLABS, R, lane, 0.5f, xin)) row_store(RESID + (size_t)R * DM, lane, v); }
            const float rs = row_rstd(v); const GAS f32x4* g = (const GAS f32x4*)INP(I_GMIX) + lane;
            float fb[8];
#pragma unroll
            for (int h = 0; h < 8; ++h) fb[h] = 0.f;
#pragma unroll
            for (int j = 0; j < 8; ++j) { v[j] = v[j] * rs * g[64 * j];
                const LAS f32x4* wf = (const LAS f32x4*)(lds + LDS_RING) + 64 * j + lane;
#pragma unroll
                for (int h = 0; h < 8; ++h) { const f32x4 w = wf[h * (DM / 4)]; fb[h] += (v[j].x * w.x + v[j].y * w.y) + (v[j].z * w.z + v[j].w * w.w); }
                __builtin_amdgcn_sched_barrier(0); }
            store_row_bf16(XN + (size_t)R * DM, lane, v);
            float mine = 0.f;
#pragma unroll
            for (int h = 0; h < 8; ++h) { const float t = wave_sum(fb[h]); if (lane == h) mine = t; }
            if (lane < 8) {
                const float z = mine + INP(I_BF)[lane];
                const float lf = fminf(z, 0.f) - log1pf(expf(-fabsf(z)));
                if (R < 32768) out[O_LFP + ((size_t)((R >> 13) * SEQP + 16 + (R & 8191))) * 8 + lane] = lf;
                else if (R < 34816) out[O_LFS + (size_t)(R - 32768) * 8 + lane] = lf;
                else { for (int b = 0; b < 4; ++b) out[O_LFP + ((size_t)(b * SEQP + (R - 34816))) * 8 + lane] = lf; }
            }
        }
        {
            for (int i = bx * 512 + tid; i < 4 * 4 * 48 * 128; i += G * 512) {
                const int c8 = i & 127, row = (i >> 7) % 48, bt = (i >> 7) / 48, b = bt & 3, t = bt >> 2;
                bf16* dst = (t == 0 ? KA : t == 1 ? VA : t == 2 ? KB : VB) + ((size_t)(b * PSTR + 16 + row) * 1024 + c8 * 8);
                *(GAS v4u*)dst = (v4u){0u, 0u, 0u, 0u};
            }
        }
        }
    }
    SEAM(3);
    if (IN(4)) {
        PH_PTRS;
        if (G - 1 - bx < 36 && G >= 36) {
            const int s = G - 1 - bx, head = tid & 7, seg = tid >> 3;
            const bool pr = s < 4; const int L = pr ? SEQP : SSTR, sl = pr ? 129 : 33;
            const int i0 = seg * sl, i1 = (i0 + sl < L) ? i0 + sl : L;
            const float* lfp = pr ? out + O_LFP + (size_t)s * SEQP * 8 : nullptr;
            const float* lfc = pr ? nullptr : INP(I_CLF) + (size_t)(s - 4) * 2048 * 8; const float* lfn = pr ? nullptr : out + O_LFS + (size_t)(s - 4) * 64 * 8;
#define LF_AT(i) (pr ? lfp[(size_t)(i) * 8 + head] : ((i) < 2048 ? lfc[(size_t)(i) * 8 + head] : lfn[(size_t)((i) - 2048) * 8 + head]))
            float acc = 0.f;
            for (int k = i0; k < i1; k += 16) { float v[16];
#pragma unroll
                for (int u = 0; u < 16; ++u) v[u] = (k + u < i1) ? LF_AT(k + u) : 0.f;
#pragma unroll
                for (int u = 0; u < 16; ++u) acc += v[u]; }
            LAS float* ps = (LAS float*)(lds + LDS_RING);
            ps[seg * 8 + head] = acc;
            __syncthreads();
            float run = 0.f;
            for (int q = 0; q < seg; ++q) run += ps[q * 8 + head];
            float* cth = CT + (size_t)head * NSR + (pr ? (size_t)s * PSTR : (size_t)SROW_S0 + (size_t)(s - 4) * SSTR);
            for (int k = i0; k < i1; k += 16) { float v[16];
#pragma unroll
                for (int u = 0; u < 16; ++u) v[u] = (k + u < i1) ? LF_AT(k + u) : 0.f;
#pragma unroll
                for (int u = 0; u < 16; ++u) { run += v[u]; const int i = k + u; if (i < i1) cth[pr ? (i < 16 ? i : 48 + i) : i] = run * 1.4426950408889634f; } }
#undef LF_AT
            if (pr && tid < 48 * 8) CT[(size_t)(tid & 7) * NSR + (size_t)s * PSTR + 16 + (tid >> 3)] = 0.f;
            __syncthreads();
        }
        pg8::Gemm g{XN, WINT, M1, NQKV, DM, DM}; pg8::StaticOrder S; S.init(M1, NQKV, G, bx);
        for (int i = tid; i < 512; i += 512) ((LAS float*)(lds + LDS_SCR + 8192))[i] = GAINS[i];
        __syncthreads();
        pg8::EpiQKV E{out, QA, KA, (const PG8_LAS float*)(lds + LDS_SCR + 8192), (PG8_LAS float*)(lds + LDS_SCR), (size_t)(WS_QB - WS_QA) / 2, SBUF / 2, O_AKP, O_AVP - O_AKP, O_AKS, O_AVS - O_AKS};
#ifndef MK_P4_REP
#define MK_P4_REP 1
#endif
        for (int rep4 = 0; rep4 < MK_P4_REP; ++rep4)
        pg8::gemm_phase<pg8::EpiQKV, pg8::StaticOrder, true, true>(lds + LDS_RING, g, S, E);
    }
    SEAM(4);
    if (IN(5)) {
        PH_PTRS;
        const float lam = ((const float*)ctl)[CW_LAM], prune_thr = ((const float*)ctl)[CW_PRUNE];
#ifndef MK_ATT_REP
#define MK_ATT_REP 1
#endif
        const int myq = (int)(xb_xcc_id() & 7u); int qsel = 0;
        for (;;) {
            if (tid == 0) {
                unsigned w = 0x7fffffffu; int qq = myq;
                for (; qsel < 8; ++qsel) { qq = (myq + qsel) & 7; w = __hip_atomic_fetch_add(ctl + CW_QUEUE + 64 * qq, 1u, RLX_AGENT); if (w < (unsigned)att::N_Q_UNITS) break; }
                *(volatile LAS unsigned*)(lds + att::A_QW) = (qsel < 8) ? w : 0x7fffffffu; *(volatile LAS unsigned*)(lds + att::A_QW + 4) = (unsigned)qq;
            }
            asm volatile("s_waitcnt vmcnt(0) lgkmcnt(0)" ::: "memory"); __builtin_amdgcn_s_barrier(); asm volatile("" ::: "memory");
            const int w = __builtin_amdgcn_readfirstlane(*(volatile LAS unsigned*)(lds + att::A_QW)), qq = __builtin_amdgcn_readfirstlane(*(volatile LAS unsigned*)(lds + att::A_QW + 4));
            att::UnitP U;
            if (w >= att::N_Q_UNITS || !att::decode_unit(qq, w, U)) break;
            if (MK_ATT_A && (U.kind == 0 || U.kind == 2)) att::attn_unit_a16(lds, U, QA, KA, VA, INP(I_GOA), lam, XN, INP(I_CAK), INP(I_CAV), wid, lane);
            else if (MK_ATT_B) att::attn_unit<128, true>(lds, U, QB, KB, VB, CT, INP(I_GOB), lam, prune_thr, XN, INP(I_CBK), INP(I_CBV), wid, lane);
        }
    }
    SEAM(5);
    if (IN(6)) {
        PH_PTRS;
        pg8::Gemm g{XN, WOT, MA, DM, DM, DM}; pg8::StaticOrder S; S.init(MA, DM, G, bx); if (MK_SPLITK) S.nr = S.nwg / G;
        pg8::EpiResid<0> E{RESID, nullptr, nullptr, nullptr, 1.0f};
        pg8::gemm_phase<pg8::EpiResid<0>, pg8::StaticOrder, true, true>(lds + LDS_RING, g, S, E);
        pg8::Gemm g4{XN, WOT, MA, DM, DM / 4, DM}; pg8::TailOrder T; T.init(MA, DM, G, bx, 4, DM / 4);
        pg8::EpiSlab EA{SLABS};
        if (MK_SPLITK) pg8::gemm_phase<pg8::EpiSlab, pg8::TailOrder, true, true>(lds + LDS_RING, g4, T, EA);
    }
    SEAM(6);
    if (IN(7)) {
        PH_PTRS;
#ifndef MK_P7_REP
#define MK_P7_REP 1
#endif
        static_assert(!MK_SPLITK, "two-row passes carry no tail fix-up");
        for (int R = gw; R < MA; R += 2 * NGW) {
            const int R2 = R + NGW; const bool has2 = R2 < MA;
            f32x4 v[8], w[8]; row_load(RESID + (size_t)R * DM, lane, v); if (has2) row_load(RESID + (size_t)R2 * DM, lane, w);
            const GAS f32x4* g = (const GAS f32x4*)INP(I_GF2) + lane;
            const float rs = row_rstd(v);
#pragma unroll
            for (int j = 0; j < 8; ++j) v[j] = v[j] * rs * g[64 * j];
            store_row_bf16(XN + (size_t)R * DM, lane, v);
            if (has2) { const float rs2 = row_rstd(w);
#pragma unroll
                for (int j = 0; j < 8; ++j) w[j] = w[j] * rs2 * g[64 * j];
                store_row_bf16(XN + (size_t)R2 * DM, lane, w); }
        }
    }
    SEAM(7);
    if (IN(8)) {
        PH_PTRS;
        pg8::Gemm g{XN, W13B, MA, 2 * FF, DM, DM}; pg8::StaticOrder S; S.init(MA, 2 * FF, G, bx);
        pg8::EpiSwiGLU E{HB, FF};
        pg8::gemm_phase<pg8::EpiSwiGLU, pg8::StaticOrder, true, true>(lds + LDS_RING, g, S, E);
    }
    SEAM(8);
    if (IN(9)) {
        PH_PTRS;
        pg8::Gemm g{HB, W2B, MA, DM, FF, FF}; pg8::StaticOrder S; S.init(MA, DM, G, bx); if (MK_SPLITK) S.nr = S.nwg / G;
        pg8::EpiResid<0> E{RESID, nullptr, nullptr, nullptr, 0.5f};
        pg8::gemm_phase<pg8::EpiResid<0>, pg8::StaticOrder, true, true>(lds + LDS_RING, g, S, E);
        pg8::Gemm g4{HB, W2B, MA, DM, FF / 4, FF}; pg8::TailOrder T; T.init(MA, DM, G, bx, 4, FF / 4);
        pg8::EpiSlab EA{SLABS};
        if (MK_SPLITK) pg8::gemm_phase<pg8::EpiSlab, pg8::TailOrder, true, true>(lds + LDS_RING, g4, T, EA);
    }
    SEAM(9);
    if (IN(10)) {
        PH_PTRS;
#ifndef MK_P10_REP
#define MK_P10_REP 1
#endif
        LAS unsigned short* ttab = (LAS unsigned short*)(lds + LDS_SCR);
        if (MK_SPLITK) build_tail_table(ttab, MA, G, tid);
        for (int R = gw; R < MA; R += 2 * NGW) {
            const int R2 = R + NGW; const bool has2 = R2 < MA;
            f32x4 v[8], w[8]; row_load(RESID + (size_t)R * DM, lane, v); if (has2) row_load(RESID + (size_t)R2 * DM, lane, w);
            const GAS f32x4* g = (const GAS f32x4*)INP(I_GFIN) + lane;
            const float rs = row_rstd(v);
            GAS f32x4* o = (GAS f32x4*)(out + O_YP + (size_t)R * DM) + lane;
#pragma unroll
            for (int j = 0; j < 8; ++j) o[64 * j] = v[j] * rs * g[64 * j];
            if (has2) { const float rs2 = row_rstd(w); GAS f32x4* o2 = (GAS f32x4*)(out + O_YP + (size_t)R2 * DM) + lane;
#pragma unroll
                for (int j = 0; j < 8; ++j) o2[64 * j] = w[j] * rs2 * g[64 * j]; }
        }
    }
#undef IN
#undef SEAM
}

extern "C" void kernel_launch(void* const* d_in, const int* in_sizes, int n_in, void* d_out, int out_size, void* d_ws, size_t ws_size, hipStream_t stream) {
    static int grid = 0;
    if (grid == 0) {
        if (n_in != 31 || (size_t)out_size != O_END || ws_size < WS_END) { fprintf(stderr, "kernel_launch: shape mismatch: n_in %d out %d ws %zu (need %zu)\n", n_in, out_size, ws_size, (size_t)WS_END); grid = -1; return; }
        int dev = 0, cus = 0, per_cu = 0;
        if (hipGetDevice(&dev) != hipSuccess || hipDeviceGetAttribute(&cus, hipDeviceAttributeMultiprocessorCount, dev) != hipSuccess) { grid = -1; return; }
        if (hipFuncSetAttribute((const void*)fwd, hipFuncAttributeMaxDynamicSharedMemorySize, LDS_BYTES) != hipSuccess) { fprintf(stderr, "kernel_launch: hipFuncSetAttribute failed\n"); grid = -1; return; }
        if (hipOccupancyMaxActiveBlocksPerMultiprocessor(&per_cu, (const void*)fwd, 512, LDS_BYTES) != hipSuccess || per_cu < 1) { fprintf(stderr, "kernel_launch: occupancy query says %d\n", per_cu); }
        (void)hipGetLastError();
        grid = cus;
    }
    if (grid < 0) return;
    if (hipMemsetAsync((char*)d_ws + WS_CTL, 0, CTL_ZERO_BYTES, stream) != hipSuccess) return;
    Args a{};
    for (int i = 0; i < 31; ++i) a.in[i] = (const float*)d_in[i];
    a.out = (float*)d_out; a.ws = (unsigned char*)d_ws;
#if MK_PER_PHASE
    for (int p = 0; p < N_PHASES; ++p) { a.ph_lo = p; a.ph_hi = p + 1; hipLaunchKernelGGL(fwd, dim3(grid), dim3(512), LDS_BYTES, stream, a); }
#else
#ifdef MK_PROBE_SPLIT
    a.ph_lo = 0; a.ph_hi = MK_PROBE_SPLIT + 1; a.li = 0;
    hipLaunchKernelGGL(fwd, dim3(grid), dim3(512), LDS_BYTES, stream, a);
    a.ph_lo = MK_PROBE_SPLIT; a.ph_hi = N_PHASES; a.li = 1;
    hipLaunchKernelGGL(fwd, dim3(grid), dim3(512), LDS_BYTES, stream, a);
#else
    a.ph_lo = 0; a.ph_hi = N_PHASES;
    hipLaunchKernelGGL(fwd, dim3(grid), dim3(512), LDS_BYTES, stream, a);
#endif
#endif
    const hipError_t le = hipPeekAtLastError();
    if (le != hipSuccess) fprintf(stderr, "kernel_launch: launch failed: %s\n", hipGetErrorName(le));
}
```

```cpp
#include <hip/hip_runtime.h>
#include <cstdio>
#include <cstdint>

#ifndef MK_PER_PHASE
#define MK_PER_PHASE 0
#endif

namespace pg8 {
#define PG8_LAS __attribute__((address_space(3)))
typedef unsigned short bf16_t;
typedef short bf16x8 __attribute__((ext_vector_type(8)));
typedef float f32x4 __attribute__((ext_vector_type(4)));
typedef unsigned u32x4 __attribute__((ext_vector_type(4)));
constexpr int BM = 256, BK = 64, HALF = 128, HTB = HALF * BK * 2  , STAGE_BYTES = 8 * HTB, NXCD = 8, WGM = 8;

__host__ __device__ __forceinline__ int lds_byte(int r, int c) { const int st = (r >> 4) * 2 + (c >> 5), rr = r & 15, cc = c & 31, ob = rr * 64 + cc * 2; return st * 1024 + (ob ^ (((ob >> 9) & 1) << 5)); }
__host__ __device__ __forceinline__ void stage_rc(int b, int& R, int& C) { const int st = b / 1024, sb = b % 1024, swz = sb ^ (((sb >> 9) & 1) << 5); R = (st >> 1) * 16 + swz / 64; C = (st & 1) * 32 + (swz % 64) / 2; }
__host__ __device__ __forceinline__ int perm32(int rho) { const int n = rho >> 4, i = rho & 15; return 8 * (i >> 2) + 4 * n + (i & 3); }

struct Unit { int pm, pn, ko, si; };
struct Gemm { const bf16_t* A; const bf16_t* Bt; int M, N, K, ld; };

struct StaticOrder {
    int nM, nN, nwg, G, c, nr;
    __host__ __device__ __forceinline__ void init(int M, int N, int G_, int c_) { nM = M / BM; nN = N / BM; nwg = nM * nN; G = G_; c = c_; nr = 1 << 30; }
    __host__ __device__ __forceinline__ void decode(int wgid, Unit& u) const {
        { const int q = nwg / NXCD, r = nwg % NXCD, xcd = wgid % NXCD, off = wgid / NXCD; wgid = (xcd < r ? xcd * (q + 1) : r * (q + 1) + (xcd - r) * q) + off; }
        const int nig = WGM * nN, gid = wgid / nig, fm = gid * WGM, gsz = (nM - fm) < WGM ? (nM - fm) : WGM;
        u.pm = fm + ((wgid % nig) % gsz); u.pn = (wgid % nig) / gsz; u.ko = 0; u.si = 0;
    }
    __host__ __device__ __forceinline__ bool next(int i, Unit& u) const {
        const long L = (long)i * G + c; if (L >= nwg || i >= nr) return false;
        decode((int)L, u); u.si = i; return true;
    }
    __device__ __forceinline__ void a_ready(const Unit&) const {}
    __device__ __forceinline__ void done(const Unit&) const {}
};
struct TailOrder {
    StaticOrder S; int base, nitems, split, kpart;
    __host__ __device__ __forceinline__ void init(int M, int N, int G_, int c_, int split_, int kpart_) { S.init(M, N, G_, c_); base = (S.nwg / G_) * G_; split = split_; kpart = kpart_; nitems = (S.nwg - base) * split_; }
    __host__ __device__ __forceinline__ bool next(int i, Unit& u) const {
        const int I = i * S.G + S.c; if (I >= nitems) return false;
        S.decode(base + I / split, u); u.ko = (I % split) * kpart; u.si = I; return true;
    }
    __device__ __forceinline__ void a_ready(const Unit&) const {}
    __device__ __forceinline__ void done(const Unit&) const {}
};
__device__ __forceinline__ unsigned cvt_pk_bf16(float lo, float hi) { unsigned r; asm volatile("v_cvt_pk_bf16_f32 %0, %1, %2" : "=v"(r) : "v"(lo), "v"(hi)); return r; }
typedef unsigned u32x2 __attribute__((ext_vector_type(2)));

constexpr int R_SMP = 32768, R_META = 34816, R_END = 34832;
constexpr int SEQP_ = 8208, PSTR_ = 8256, SSTR_ = 2112, SROW_S0_ = 4 * 8256;

template <bool SCALE> struct EpiSwiGLU {
    static constexpr bool PERM = true, AFTER_DRAIN = false;
    bf16_t* H; const PG8_LAS float* RT; int ldh;
    __device__ __forceinline__ void operator()(const f32x4 (&acc)[2][2][4][2], const Unit& u, int wr, int wc, int fr, int fq) const {
        const int row0 = u.pm * BM + wr * 64 + fr, col0 = u.pn * HALF + wc * 32 + 8 * fq;
#pragma unroll
        for (int ai = 0; ai < 2; ++ai)
#pragma unroll
            for (int m = 0; m < 4; ++m) {
                bf16_t* rowp = H + (size_t)(row0 + ai * HALF + m * 16) * ldh + col0;
                const float rr = SCALE ? RT[u.si * 256 + ai * HALF + wr * 64 + m * 16 + fr] : 1.0f;
                float h[8];
#pragma unroll
                for (int n = 0; n < 2; ++n)
#pragma unroll
                    for (int i = 0; i < 4; ++i) { const float g = acc[ai][0][m][n][i] * rr, up = acc[ai][1][m][n][i] * rr;
                        const float e = __builtin_amdgcn_exp2f(-1.4426950408889634f * g);
                        h[n * 4 + i] = g * __builtin_amdgcn_rcpf(1.0f + e) * up; }
                u32x4 w; w.x = cvt_pk_bf16(h[0], h[1]); w.y = cvt_pk_bf16(h[2], h[3]); w.z = cvt_pk_bf16(h[4], h[5]); w.w = cvt_pk_bf16(h[6], h[7]);
                *(u32x4*)rowp = w;
            }
    }
};

template <int MODE> struct EpiResid {
    static constexpr bool PERM = false, AFTER_DRAIN = false;
    float* out; const float* xp; const float* xs; const float* meta; float alpha;
    __device__ __forceinline__ void operator()(const f32x4 (&acc)[2][2][4][2], const Unit& u, int wr, int wc, int fr, int fq) const {
        const int row0 = u.pm * BM + wr * 64 + fr, col0 = u.pn * BM + wc * 32 + 4 * fq;
#pragma unroll
        for (int ai = 0; ai < 2; ++ai) {
            f32x4 b[4][2][2];
#pragma unroll
            for (int m = 0; m < 4; ++m) {
                const int R = row0 + ai * HALF + m * 16;
                const float* bp;
                if (MODE == 0) bp = out + (size_t)R * 2048 + col0;
                else bp = (R < R_SMP) ? xp + (size_t)R * 2048 + col0 : (R < R_META) ? xs + (size_t)(R - R_SMP) * 2048 + col0 : (R < R_END) ? meta + (size_t)(R - R_META) * 2048 + col0 : nullptr;
#pragma unroll
                for (int bj = 0; bj < 2; ++bj)
#pragma unroll
                    for (int n = 0; n < 2; ++n) { b[m][bj][n] = (f32x4){0.f, 0.f, 0.f, 0.f}; if (MODE == 0 || bp) b[m][bj][n] = *(const f32x4*)(bp + bj * HALF + n * 16); }
            }
            __builtin_amdgcn_sched_barrier(0);
#pragma unroll
            for (int m = 0; m < 4; ++m) {
                float* op = out + (size_t)(row0 + ai * HALF + m * 16) * 2048 + col0;
#pragma unroll
                for (int bj = 0; bj < 2; ++bj)
#pragma unroll
                    for (int n = 0; n < 2; ++n) *(f32x4*)(op + bj * HALF + n * 16) = b[m][bj][n] + acc[ai][bj][m][n] * alpha;
            }
            __builtin_amdgcn_sched_barrier(0);
        }
    }
};

template <int MODE, bool FG> struct EpiResidN {
    static constexpr bool PERM = false, AFTER_DRAIN = false;
    float* out; const float* xp; const float* xs; const float* meta; bf16_t* side; float* ssq; float* fgp; const u32x4* wfb; PG8_LAS float* P; int ldp; float alpha;
    __device__ __forceinline__ void operator()(const f32x4 (&acc)[2][2][4][2], const Unit& u, int wr, int wc, int fr, int fq) const {
        const int row0 = u.pm * BM + wr * 64 + fr, col0 = u.pn * BM + wc * 32 + 4 * fq;
        bf16x8 wf[2];
        if constexpr (FG) {
#pragma unroll
            for (int bj = 0; bj < 2; ++bj) wf[bj] = __builtin_bit_cast(bf16x8, wfb[(u.pn * 8 + bj * 4 + wc) * 64 + fq * 16 + fr]);
        }
#pragma unroll
        for (int ai = 0; ai < 2; ++ai) {
            f32x4 b[4][2][2];
#pragma unroll
            for (int m = 0; m < 4; ++m) {
                const int R = row0 + ai * HALF + m * 16;
                const float* bp;
                if (MODE == 0) bp = out + (size_t)R * 2048 + col0;
                else bp = (R < R_SMP) ? xp + (size_t)R * 2048 + col0 : (R < R_META) ? xs + (size_t)(R - R_SMP) * 2048 + col0 : (R < R_END) ? meta + (size_t)(R - R_META) * 2048 + col0 : nullptr;
#pragma unroll
                for (int bj = 0; bj < 2; ++bj)
#pragma unroll
                    for (int n = 0; n < 2; ++n) { b[m][bj][n] = (f32x4){0.f, 0.f, 0.f, 0.f}; if (MODE == 0 || bp) b[m][bj][n] = *(const f32x4*)(bp + bj * HALF + n * 16); }
            }
            __builtin_amdgcn_sched_barrier(0);
#pragma unroll
            for (int m = 0; m < 4; ++m) {
                const int R = row0 + ai * HALF + m * 16;
                float* op = out + (size_t)R * 2048 + col0; bf16_t* sp = side + (size_t)R * 2048 + col0;
                float s = 0.f; f32x4 fg = (f32x4){0.f, 0.f, 0.f, 0.f};
#pragma unroll
                for (int bj = 0; bj < 2; ++bj) {
                    u32x2 w[2];
#pragma unroll
                    for (int n = 0; n < 2; ++n) { const f32x4 v = b[m][bj][n] + acc[ai][bj][m][n] * alpha;
                        *(f32x4*)(op + bj * HALF + n * 16) = v; s += (v[0] * v[0] + v[1] * v[1]) + (v[2] * v[2] + v[3] * v[3]);
                        w[n].x = cvt_pk_bf16(v[0], v[1]); w[n].y = cvt_pk_bf16(v[2], v[3]); *(u32x2*)(sp + bj * HALF + n * 16) = w[n]; }
                    if constexpr (FG) { u32x4 aw; aw.x = w[0].x; aw.y = w[0].y; aw.z = w[1].x; aw.w = w[1].y;
                        fg = __builtin_amdgcn_mfma_f32_16x16x32_bf16(wf[bj], __builtin_bit_cast(bf16x8, aw), fg, 0, 0, 0); }
                }
                s += __shfl_xor(s, 16); s += __shfl_xor(s, 32);
                if (fq == 0) P[(ai * HALF + wr * 64 + m * 16 + fr) * 4 + wc] = s;
                if constexpr (FG) { if (fq < 2) *(f32x4*)(fgp + ((size_t)(u.pn * 4 + wc) * ldp + R) * 8 + 4 * fq) = fg; }
            }
            __builtin_amdgcn_sched_barrier(0);
        }
        asm volatile("s_waitcnt lgkmcnt(0)" ::: "memory"); __builtin_amdgcn_s_barrier(); asm volatile("" ::: "memory");
        {
            const int wid = wr * 4 + wc, lane = fq * 16 + fr;
            if (lane < 32) { const int row = wid * 32 + lane; const f32x4 q = *(const PG8_LAS f32x4*)(P + row * 4); ssq[(size_t)u.pn * ldp + u.pm * BM + row] = (q[0] + q[1]) + (q[2] + q[3]); }
        }
    }
};

struct EpiSlab {
    static constexpr bool PERM = false, AFTER_DRAIN = false;
    float* slabs;
    __device__ __forceinline__ void operator()(const f32x4 (&acc)[2][2][4][2], const Unit& u, int wr, int wc, int fr, int fq) const {
        float* sb = slabs + (size_t)u.si * 65536 + (size_t)(wr * 64 + fr) * 256 + wc * 32 + 4 * fq;
#pragma unroll
        for (int ai = 0; ai < 2; ++ai)
#pragma unroll
            for (int m = 0; m < 4; ++m)
#pragma unroll
                for (int bj = 0; bj < 2; ++bj)
#pragma unroll
                    for (int n = 0; n < 2; ++n) *(f32x4*)(sb + (size_t)(ai * HALF + m * 16) * 256 + bj * HALF + n * 16) = acc[ai][bj][m][n];
    }
};

struct EpiQKV {
    static constexpr bool PERM = false, AFTER_DRAIN = false;
    float* out; bf16_t* QA; bf16_t* KA; const PG8_LAS float* gains; PG8_LAS float* P; const PG8_LAS float* RT;
    size_t q_stride, s_stride, o_p0, o_pstride, o_s0, o_sstride;
    __device__ __forceinline__ void operator()(const f32x4 (&acc)[2][2][4][2], const Unit& u, int wr, int wc, int fr, int fq) const {
        asm volatile("" : "+v"(fr), "+v"(fq));
        const int grp = u.pn >> 2, tcol = (u.pn & 3) * 256;
        const bool normed = (grp != 2 && grp != 5), roped = grp < 2, isq = (grp == 0 || grp == 3);
        if (normed) {
#pragma unroll
            for (int ai = 0; ai < 2; ++ai)
#pragma unroll
                for (int m = 0; m < 4; ++m)
#pragma unroll
                    for (int bj = 0; bj < 2; ++bj) {
                        const f32x4 a = acc[ai][bj][m][0], b = acc[ai][bj][m][1];
                        float s = (a[0] * a[0] + a[1] * a[1]) + (a[2] * a[2] + a[3] * a[3]) + (b[0] * b[0] + b[1] * b[1]) + (b[2] * b[2] + b[3] * b[3]);
                        s += __shfl_xor(s, 16); s += __shfl_xor(s, 32);
                        if (fq == 0) P[((ai * HALF + wr * 64 + m * 16 + fr) * 2 + bj) * 4 + wc] = s;
                    }
            asm volatile("s_waitcnt lgkmcnt(0)" ::: "memory"); __builtin_amdgcn_s_barrier(); asm volatile("" ::: "memory");
        }
        f32x4 g[2];
        {
            const PG8_LAS float* gv = gains + (grp < 2 ? grp : grp - 1) * 128;
            const float qs = isq ? 0.08838834764831845f * 1.4426950408889634f : 1.0f;
#pragma unroll
            for (int n = 0; n < 2; ++n) g[n] = normed ? *(const PG8_LAS f32x4*)(gv + wc * 32 + n * 16 + 4 * fq) * qs : (f32x4){1.f, 1.f, 1.f, 1.f};
        }
        const int sidx_ = grp - 1 - (grp > 3 ? 1 : 0);
        bf16_t* sbuf = KA + (size_t)(sidx_ < 0 ? 0 : sidx_) * s_stride;
        bf16_t* qbuf = QA + (grp == 3 ? q_stride : 0);
        const size_t o_p = o_p0 + (size_t)(sidx_ < 0 ? 0 : sidx_) * o_pstride;
        const size_t o_s = o_s0 + (size_t)(sidx_ < 0 ? 0 : sidx_) * o_sstride;
        const int colw = tcol + wc * 32 + 4 * fq;
#pragma unroll
        for (int ai = 0; ai < 2; ++ai)
#pragma unroll
            for (int m = 0; m < 4; ++m) {
                const int R = u.pm * BM + ai * HALF + wr * 64 + m * 16 + fr;
                const float rr = RT[u.si * 256 + ai * HALF + wr * 64 + m * 16 + fr];
                float rstd2[2] = {rr, rr};
                if (normed) {
#pragma unroll
                    for (int bj = 0; bj < 2; ++bj) { const f32x4 q = *(const PG8_LAS f32x4*)(P + ((ai * HALF + wr * 64 + m * 16 + fr) * 2 + bj) * 4);
                        rstd2[bj] = rr * __builtin_amdgcn_rsqf(((q[0] + q[1]) + (q[2] + q[3])) * (rr * rr * (1.0f / 128.0f)) + 1e-6f); }
                }
                if (R < R_END) {
                f32x4 cs = (f32x4){1.f, 1.f, 1.f, 1.f}, sn = (f32x4){0.f, 0.f, 0.f, 0.f};
                if (roped && wc == 0) {
                    const int pos = (R < R_SMP) ? 16 + (R & 8191) : (R < R_META) ? 2048 + (R & 63) : (R - R_META);
                    const float fp = (float)pos;
#pragma unroll
                    for (int i = 0; i < 4; ++i) { float rev = fp * (__builtin_amdgcn_exp2f(-(float)(4 * fq + i) * (18.931568569324174f / 16.0f)) * 0.15915494309189535f);
                        rev = __builtin_amdgcn_fractf(rev); cs[i] = __builtin_amdgcn_cosf(rev); sn[i] = __builtin_amdgcn_sinf(rev); }
                }
#pragma unroll
                for (int bj = 0; bj < 2; ++bj) {
                    f32x4 v0 = acc[ai][bj][m][0] * rstd2[bj] * g[0], v1 = acc[ai][bj][m][1] * rstd2[bj] * g[1];
                    if (roped && wc == 0) { const f32x4 x1 = v0, x2 = v1; v0 = x1 * cs - x2 * sn; v1 = x2 * cs + x1 * sn; }
                    const int col = colw + bj * HALF;
                    u32x2 w0, w1; w0.x = cvt_pk_bf16(v0[0], v0[1]); w0.y = cvt_pk_bf16(v0[2], v0[3]); w1.x = cvt_pk_bf16(v1[0], v1[1]); w1.y = cvt_pk_bf16(v1[2], v1[3]);
                    if (isq) {
                        if (R < R_META) { bf16_t* q = qbuf + (size_t)R * 1024 + col; *(u32x2*)q = w0; *(u32x2*)(q + 16) = w1; }
                    } else if (R < R_SMP) {
                        const int b = R >> 13, t = R & 8191;
                        float* o = out + o_p + ((size_t)(b * SEQP_ + 16 + t) * 1024 + col); *(f32x4*)o = v0; *(f32x4*)(o + 16) = v1;
                        bf16_t* s = sbuf + ((size_t)(b * PSTR_ + 64 + t) * 1024 + col); *(u32x2*)s = w0; *(u32x2*)(s + 16) = w1;
                    } else if (R < R_META) {
                        const int sidx = (R - R_SMP) >> 6, i = R & 63;
                        float* o = out + o_s + ((size_t)(R - R_SMP) * 1024 + col); *(f32x4*)o = v0; *(f32x4*)(o + 16) = v1;
                        bf16_t* s = sbuf + ((size_t)(SROW_S0_ + sidx * SSTR_ + 2048 + i) * 1024 + col); *(u32x2*)s = w0; *(u32x2*)(s + 16) = w1;
                    } else {
                        const int mi = R - R_META;
#pragma unroll
                        for (int b = 0; b < 4; ++b) {
                            float* o = out + o_p + ((size_t)(b * SEQP_ + mi) * 1024 + col); *(f32x4*)o = v0; *(f32x4*)(o + 16) = v1;
                            bf16_t* s = sbuf + ((size_t)(b * PSTR_ + mi) * 1024 + col); *(u32x2*)s = w0; *(u32x2*)(s + 16) = w1;
                        }
                    }
                }
                }
                __builtin_amdgcn_sched_barrier(0);
            }
    }
};

template <class Epi, class Sched, bool ALIGN_EPI = false, bool SP2 = false>
__device__ __forceinline__ void gemm_phase(PG8_LAS unsigned char* lds, const Gemm g, const Sched& S, const Epi& E) {
    const int tid = threadIdx.x, wid = __builtin_amdgcn_readfirstlane(tid >> 6), lane = tid & 63, wr = wid >> 2, wc = wid & 3, fr = lane & 15, fq = lane >> 4;
    const int K = g.ld, nt = g.K / BK;
    unsigned voffA[2], voffB[2];
#pragma unroll
    for (int i = 0; i < 2; ++i) { int R, C; stage_rc(tid * 16 + i * 8192, R, C); const int Rb = Epi::PERM ? ((R & ~31) + perm32(R & 31)) : R;
        voffA[i] = (unsigned)(R * K + C) * 2u; voffB[i] = (unsigned)(Rb * K + C) * 2u; }
    const size_t kstep = (size_t)(BK * 2);
    const size_t hstep = (size_t)HALF * K * 2;
    const size_t tstep = 2 * hstep;
    const unsigned ldsw = (unsigned)wid * 1024u;
    const int aoff = lds_byte(wr * 64 + fr, fq * 8), boff = lds_byte(wc * 32 + fr, fq * 8);
#define PG8_SA(b, h) (((b) * 2 + (h)) * HTB)
#define PG8_SB(b, h) ((4 + (b) * 2 + (h)) * HTB)
#define PG8_STAGE(bufoff, gbase, voff) do { _Pragma("unroll") for (int _i = 0; _i < 2; ++_i) \
        __builtin_amdgcn_global_load_lds((const unsigned*)((const char*)(gbase) + (voff)[_i]), (PG8_LAS unsigned*)(lds + (bufoff) + ldsw + _i * 8192), 16, 0, 0); } while (0)
#define PG8_LDA(dst, b, h) do { _Pragma("unroll") for (int m = 0; m < 4; ++m) _Pragma("unroll") for (int k = 0; k < 2; ++k) dst[m][k] = *(const PG8_LAS bf16x8*)(lds + PG8_SA(b, h) + aoff + m * 2048 + k * 1024); } while (0)
#define PG8_LDB(dst, b, h) do { _Pragma("unroll") for (int n = 0; n < 2; ++n) _Pragma("unroll") for (int k = 0; k < 2; ++k) dst[n][k] = *(const PG8_LAS bf16x8*)(lds + PG8_SB(b, h) + boff + n * 2048 + k * 1024); } while (0)
#define PG8_MMA(ai, bj, At, Bt) do { __builtin_amdgcn_s_setprio(1); _Pragma("unroll") for (int m = 0; m < 4; ++m) _Pragma("unroll") for (int n = 0; n < 2; ++n) _Pragma("unroll") for (int k = 0; k < 2; ++k) \
        acc[ai][bj][m][n] = __builtin_amdgcn_mfma_f32_16x16x32_bf16(Bt[n][k], At[m][k], acc[ai][bj][m][n], 0, 0, 0); __builtin_amdgcn_s_setprio(0); } while (0)
#define PG8_WAIT_V(n) asm volatile("s_waitcnt vmcnt(" #n ")" ::: "memory")
#define PG8_WAIT_L(n) asm volatile("s_waitcnt lgkmcnt(" #n ")" ::: "memory")
#define PG8_BAR __builtin_amdgcn_s_barrier()
#define PG8_SCHED __builtin_amdgcn_sched_barrier(0)
    Unit cur, nxt; int ui = 0;
    if (!S.next(0, cur)) return;
    f32x4 acc[2][2][4][2];
#pragma unroll
    for (int a = 0; a < 2; ++a)
#pragma unroll
        for (int b = 0; b < 2; ++b)
#pragma unroll
            for (int m = 0; m < 4; ++m)
#pragma unroll
                for (int n = 0; n < 2; ++n) acc[a][b][m][n] = (f32x4){0.f, 0.f, 0.f, 0.f};
    bf16x8 At[4][2], B0[2][2], B1[2][2];
    const char* cA = (const char*)g.A + (size_t)cur.pm * tstep + (size_t)cur.ko * 2; const char* cB = (const char*)g.Bt + (size_t)cur.pn * tstep + (size_t)cur.ko * 2;
    S.a_ready(cur);
    if constexpr (SP2) {
        PG8_STAGE(PG8_SB(0, 0), cB, voffB); PG8_STAGE(PG8_SB(0, 1), cB + hstep, voffB); PG8_STAGE(PG8_SA(0, 0), cA, voffA); PG8_STAGE(PG8_SA(0, 1), cA + hstep, voffA);
        if (wr == 1) PG8_BAR;
        PG8_WAIT_V(2); PG8_BAR;
        PG8_STAGE(PG8_SB(1, 0), cB + kstep, voffB); PG8_STAGE(PG8_SA(1, 0), cA + kstep, voffA); PG8_STAGE(PG8_SB(1, 1), cB + hstep + kstep, voffB);
        PG8_WAIT_V(6); PG8_BAR;
    } else {
        PG8_STAGE(PG8_SB(0, 0), cB, voffB); PG8_STAGE(PG8_SA(0, 0), cA, voffA); PG8_STAGE(PG8_SB(0, 1), cB + hstep, voffB); PG8_STAGE(PG8_SA(0, 1), cA + hstep, voffA);
        if (wr == 1) PG8_BAR;
        PG8_WAIT_V(4); PG8_BAR;
        PG8_STAGE(PG8_SB(1, 0), cB + kstep, voffB); PG8_STAGE(PG8_SA(1, 0), cA + kstep, voffA); PG8_STAGE(PG8_SB(1, 1), cB + hstep + kstep, voffB);
        PG8_WAIT_V(6); PG8_BAR;
    }
    for (;;) {
        const bool has_next = S.next(ui + 1, nxt);
        const char* nA = has_next ? (const char*)g.A + (size_t)nxt.pm * tstep + (size_t)nxt.ko * 2 : cA; const char* nB = has_next ? (const char*)g.Bt + (size_t)nxt.pn * tstep + (size_t)nxt.ko * 2 : cB;
        for (int t = 0; t < nt; t += 2) {
            const bool last = (t == nt - 2);
            const char* a1 = cA + (size_t)(t + 1) * kstep;
            const char* a2 = last ? nA : cA + (size_t)(t + 2) * kstep; const char* b2 = last ? nB : cB + (size_t)(t + 2) * kstep;
            const char* a3 = a2 + kstep; const char* b3 = b2 + kstep;
            if (last && has_next) S.a_ready(nxt);
            if constexpr (SP2) {
            PG8_LDB(B0, 0, 0); PG8_LDB(B1, 0, 1); PG8_SCHED; PG8_LDA(At, 0, 0); PG8_STAGE(PG8_SA(1, 1), a1 + hstep, voffA);
            PG8_WAIT_V(8); PG8_WAIT_L(0); PG8_BAR; PG8_MMA(0, 0, At, B0); PG8_MMA(0, 1, At, B1); PG8_BAR; PG8_SCHED;
            PG8_LDA(At, 0, 1); PG8_STAGE(PG8_SB(0, 0), b2, voffB); PG8_STAGE(PG8_SB(0, 1), b2 + hstep, voffB); PG8_STAGE(PG8_SA(0, 0), a2, voffA);
            PG8_WAIT_V(8); PG8_WAIT_L(0); PG8_BAR; PG8_MMA(1, 0, At, B0); PG8_MMA(1, 1, At, B1); PG8_BAR; PG8_SCHED;
            PG8_LDB(B0, 1, 0); PG8_LDB(B1, 1, 1); PG8_SCHED; PG8_LDA(At, 1, 0); PG8_STAGE(PG8_SA(0, 1), a2 + hstep, voffA);
            PG8_WAIT_V(8); PG8_WAIT_L(0); PG8_BAR; PG8_MMA(0, 0, At, B0); PG8_MMA(0, 1, At, B1); PG8_BAR; PG8_SCHED;
            PG8_LDA(At, 1, 1); PG8_STAGE(PG8_SB(1, 0), b3, voffB); PG8_STAGE(PG8_SB(1, 1), b3 + hstep, voffB); PG8_STAGE(PG8_SA(1, 0), a3, voffA);
            PG8_WAIT_V(8); PG8_WAIT_L(0); PG8_BAR; PG8_MMA(1, 0, At, B0); PG8_MMA(1, 1, At, B1); PG8_BAR; PG8_SCHED;
            } else {
            PG8_LDB(B0, 0, 0); PG8_SCHED; PG8_LDA(At, 0, 0); PG8_STAGE(PG8_SA(1, 1), a1 + hstep, voffA);
            PG8_WAIT_L(8); PG8_BAR; PG8_WAIT_L(0); PG8_MMA(0, 0, At, B0); PG8_BAR; PG8_SCHED;
            PG8_LDB(B1, 0, 1); PG8_STAGE(PG8_SB(0, 0), b2, voffB);
            PG8_BAR; PG8_WAIT_L(0); PG8_MMA(0, 1, At, B1); PG8_BAR;
            PG8_LDA(At, 0, 1); PG8_STAGE(PG8_SA(0, 0), a2, voffA);
            PG8_BAR; PG8_WAIT_L(0); PG8_MMA(1, 0, At, B0); PG8_BAR; PG8_SCHED;
            PG8_STAGE(PG8_SB(0, 1), b2 + hstep, voffB);
            PG8_WAIT_V(6); PG8_BAR; PG8_MMA(1, 1, At, B1); PG8_BAR;
            PG8_LDB(B0, 1, 0); PG8_SCHED; PG8_LDA(At, 1, 0); PG8_STAGE(PG8_SA(0, 1), a2 + hstep, voffA);
            PG8_WAIT_L(8); PG8_BAR; PG8_WAIT_L(0); PG8_MMA(0, 0, At, B0); PG8_BAR; PG8_SCHED;
            PG8_LDB(B1, 1, 1); PG8_STAGE(PG8_SB(1, 0), b3, voffB);
            PG8_BAR; PG8_WAIT_L(0); PG8_MMA(0, 1, At, B1); PG8_BAR;
            PG8_LDA(At, 1, 1); PG8_STAGE(PG8_SA(1, 0), a3, voffA);
            PG8_BAR; PG8_WAIT_L(0); PG8_MMA(1, 0, At, B0); PG8_BAR; PG8_SCHED;
            PG8_STAGE(PG8_SB(1, 1), b3 + hstep, voffB);
            PG8_WAIT_V(6); PG8_BAR; PG8_MMA(1, 1, At, B1); PG8_BAR;
            }
        }
        if constexpr (ALIGN_EPI) { if (wr == 0) PG8_BAR; }
        if constexpr (!Epi::AFTER_DRAIN) { E(acc, cur, wr, wc, fr, fq); S.done(cur); }
        if (!has_next) break;
#pragma unroll
        for (int a = 0; a < 2; ++a)
#pragma unroll
            for (int b = 0; b < 2; ++b)
#pragma unroll
                for (int m = 0; m < 4; ++m)
#pragma unroll
                    for (int n = 0; n < 2; ++n) acc[a][b][m][n] = (f32x4){0.f, 0.f, 0.f, 0.f};
        cur = nxt; cA = nA; cB = nB; ++ui;
        if constexpr (ALIGN_EPI) { if (wr == 1) PG8_BAR; }
    }
    PG8_WAIT_V(0);
    if constexpr (!ALIGN_EPI) { if (wr == 0) PG8_BAR; }
    PG8_BAR;
    if constexpr (Epi::AFTER_DRAIN) { E.fused(acc, cur, wr, wc, fr, fq, lds, wid, lane); S.done(cur); }
#undef PG8_SA
#undef PG8_SB
#undef PG8_STAGE
#undef PG8_LDA
#undef PG8_LDB
#undef PG8_MMA
#undef PG8_WAIT_V
#undef PG8_WAIT_L
#undef PG8_BAR
#undef PG8_SCHED
}
}
namespace att {
#define ALAS __attribute__((address_space(3)))
typedef unsigned short bf16;
typedef short bf16x8 __attribute__((ext_vector_type(8)));
typedef short s16x4 __attribute__((ext_vector_type(4)));
typedef float f32x16 __attribute__((ext_vector_type(16)));
typedef float f32x4 __attribute__((ext_vector_type(4)));
typedef unsigned u32x4 __attribute__((ext_vector_type(4)));
#define KSWZ(row, colB) ((row) * 256 + ((colB) ^ (((row) & 7) << 4)))
#define ASBAR() __builtin_amdgcn_sched_barrier(0)
__device__ __forceinline__ int crow(int r, int hi) { return (r & 3) + 8 * (r >> 2) + 4 * hi; }
__device__ __forceinline__ unsigned cvtpk(float lo, float hi) { unsigned r; asm volatile("v_cvt_pk_bf16_f32 %0, %1, %2" : "=v"(r) : "v"(lo), "v"(hi)); return r; }
__device__ __forceinline__ int v_rd_base(int lane) { return ((lane & 3) << 3) | (((lane >> 2) & 3) << 6) | (((lane >> 4) & 1) << 5) | (((lane >> 5) & 1) << 8); }
constexpr int v_rd_off(int d0, int ks, int half) { return d0 * 512 + ks * 4096 + half * 2048; }
template <int OFF> __device__ __forceinline__ s16x4 tr_read(int vb) { s16x4 r; asm volatile("ds_read_b64_tr_b16 %0, %1 offset:%2" : "=&v"(r) : "v"(vb), "i"(OFF) : "memory"); return r; }
template <int D0> __device__ __forceinline__ void pv_one(f32x16& od, int vb, bf16x8 pa0, bf16x8 pa1, bf16x8 pa2, bf16x8 pa3) {
    const s16x4 l0 = tr_read<v_rd_off(D0, 0, 0)>(vb), h0 = tr_read<v_rd_off(D0, 0, 1)>(vb), l1 = tr_read<v_rd_off(D0, 1, 0)>(vb), h1 = tr_read<v_rd_off(D0, 1, 1)>(vb);
    const s16x4 l2 = tr_read<v_rd_off(D0, 2, 0)>(vb), h2 = tr_read<v_rd_off(D0, 2, 1)>(vb), l3 = tr_read<v_rd_off(D0, 3, 0)>(vb), h3 = tr_read<v_rd_off(D0, 3, 1)>(vb);
    asm volatile("s_waitcnt lgkmcnt(0)" ::: "memory"); ASBAR();
#define APK(L, H) (bf16x8){L[0], L[1], L[2], L[3], H[0], H[1], H[2], H[3]}
    od = __builtin_amdgcn_mfma_f32_32x32x16_bf16(pa0, APK(l0, h0), od, 0, 0, 0);
    od = __builtin_amdgcn_mfma_f32_32x32x16_bf16(pa1, APK(l1, h1), od, 0, 0, 0);
    od = __builtin_amdgcn_mfma_f32_32x32x16_bf16(pa2, APK(l2, h2), od, 0, 0, 0);
    od = __builtin_amdgcn_mfma_f32_32x32x16_bf16(pa3, APK(l3, h3), od, 0, 0, 0);
#undef APK
}

template <int OFF> __device__ __forceinline__ bf16x8 lds_rd128(int addr) { bf16x8 r; asm volatile("ds_read_b128 %0, %1 offset:%2" : "=&v"(r) : "v"(addr), "i"(OFF) : "memory"); return r; }
template <int D0> struct QkChain {
    static __device__ __forceinline__ void run(f32x16& p0, f32x16& p1, const bf16x8 (&qr)[8], const int (&ka)[4], bf16x8 ca, bf16x8 cb) {
        bf16x8 na, nb;
        if constexpr (D0 < 7) { na = lds_rd128<((D0 + 1) >> 2) * 128>(ka[(D0 + 1) & 3]); nb = lds_rd128<((D0 + 1) >> 2) * 128 + 8192>(ka[(D0 + 1) & 3]); asm volatile("s_waitcnt lgkmcnt(2)" ::: "memory"); }
        else { asm volatile("s_waitcnt lgkmcnt(0)" ::: "memory"); }
        ASBAR();
        p0 = __builtin_amdgcn_mfma_f32_32x32x16_bf16(ca, qr[D0], p0, 0, 0, 0);
        p1 = __builtin_amdgcn_mfma_f32_32x32x16_bf16(cb, qr[D0], p1, 0, 0, 0);
        ASBAR();
        if constexpr (D0 < 7) QkChain<D0 + 1>::run(p0, p1, qr, ka, na, nb);
    }
};
template <int B> __device__ __forceinline__ void tr8(s16x4 (&f)[8], int vb) {
    constexpr int base = (B >> 2) * 16384, D0 = B & 3;
    f[0] = tr_read<base + v_rd_off(D0, 0, 0)>(vb); f[1] = tr_read<base + v_rd_off(D0, 0, 1)>(vb); f[2] = tr_read<base + v_rd_off(D0, 1, 0)>(vb); f[3] = tr_read<base + v_rd_off(D0, 1, 1)>(vb);
    f[4] = tr_read<base + v_rd_off(D0, 2, 0)>(vb); f[5] = tr_read<base + v_rd_off(D0, 2, 1)>(vb); f[6] = tr_read<base + v_rd_off(D0, 3, 0)>(vb); f[7] = tr_read<base + v_rd_off(D0, 3, 1)>(vb);
}
__device__ __forceinline__ void pv4(f32x16& od, const s16x4 (&f)[8], bf16x8 pa0, bf16x8 pa1, bf16x8 pa2, bf16x8 pa3) {
#define APK(L, H) (bf16x8){L[0], L[1], L[2], L[3], H[0], H[1], H[2], H[3]}
    od = __builtin_amdgcn_mfma_f32_32x32x16_bf16(pa0, APK(f[0], f[1]), od, 0, 0, 0);
    od = __builtin_amdgcn_mfma_f32_32x32x16_bf16(pa1, APK(f[2], f[3]), od, 0, 0, 0);
    od = __builtin_amdgcn_mfma_f32_32x32x16_bf16(pa2, APK(f[4], f[5]), od, 0, 0, 0);
    od = __builtin_amdgcn_mfma_f32_32x32x16_bf16(pa3, APK(f[6], f[7]), od, 0, 0, 0);
#undef APK
}
template <int NB, int B = 0> struct PvChain {
    static __device__ __forceinline__ void run(f32x16* o, int vb, s16x4 (&cur)[8], bf16x8 pa0, bf16x8 pa1, bf16x8 pa2, bf16x8 pa3) {
        s16x4 nxt[8];
        if constexpr (B + 1 < NB) { tr8<B + 1>(nxt, vb); asm volatile("s_waitcnt lgkmcnt(8)" ::: "memory"); }
        else { asm volatile("s_waitcnt lgkmcnt(0)" ::: "memory"); }
        ASBAR();
        pv4(o[B], cur, pa0, pa1, pa2, pa3);
        ASBAR();
        if constexpr (B + 1 < NB) PvChain<NB, B + 1>::run(o, vb, nxt, pa0, pa1, pa2, pa3);
    }
};
template <int NB> __device__ __forceinline__ void pv_all(f32x16* o, int vb, bf16x8 pa0, bf16x8 pa1, bf16x8 pa2, bf16x8 pa3) {
    s16x4 f0[8]; tr8<0>(f0, vb);
    PvChain<NB, 0>::run(o, vb, f0, pa0, pa1, pa2, pa3);
}

constexpr int A_RING = 131072;
constexpr int A_WS = 131072 + 256;
constexpr int A_CK = A_WS + 2048;
constexpr int A_QW = 131072 + 16;
constexpr float THR2 = 11.5f;

template <int PPR, int NPT> __device__ __forceinline__ void conv_tile(const float* __restrict__ ck, const float* __restrict__ cv, bf16* __restrict__ dk, bf16* __restrict__ dv, int tile, int ct, int nct) {
    constexpr int NP = 64 * PPR;
    f32x4 x[2 * NPT];
#pragma unroll
    for (int u = 0; u < NPT; ++u) { const int p = ct + u * nct;
        if (p < 2 * NP) { const int q = p % NP; const float* src = ((p < NP) ? ck : cv) + (size_t)(64 * tile + q / PPR) * 1024 + (q % PPR) * 8; x[2 * u] = *(const f32x4*)src; x[2 * u + 1] = *(const f32x4*)(src + 4); } }
#pragma unroll
    for (int u = 0; u < NPT; ++u) { const int p = ct + u * nct;
        if (p < 2 * NP) { const int q = p % NP; bf16* dst = ((p < NP) ? dk : dv) + (size_t)(64 * tile + q / PPR) * 1024 + (q % PPR) * 8;
            u32x4 w = {cvtpk(x[2 * u][0], x[2 * u][1]), cvtpk(x[2 * u][2], x[2 * u][3]), cvtpk(x[2 * u + 1][0], x[2 * u + 1][1]), cvtpk(x[2 * u + 1][2], x[2 * u + 1][3])};
            *(u32x4*)dst = w; } }
}

struct UnitP {
    int kind;
    int h;
    long orow0;
    long srow0;
    int ntiles;
    int qb;
};

template <int DV, bool FOX>
__device__ __forceinline__ void attn_unit(ALAS unsigned char* lds, const UnitP U, const bf16* __restrict__ Qg, const bf16* __restrict__ Kg, const bf16* __restrict__ Vg,
                                          const float* __restrict__ cT, const float* __restrict__ gout, float lam, float prune_thr, bf16* __restrict__ merged,
                                          const float* __restrict__ cacheK, const float* __restrict__ cacheV, int wid, int lane) {
    constexpr int NS = DV / 128;
    constexpr int STAGE = 2 * NS * 16384;
    asm volatile("" : "+v"(lane));
    const int r32 = lane & 31, hi = lane >> 5;
    const bool sample = U.kind >= 2;
    const int rg = (DV == 256) ? (wid & 3) : wid, map = (DV == 256) ? (wid >> 2) : 0;
    const bool active = sample ? (rg < 2) : true;
    int wlast, jd, dq0; const int lim0 = sample ? 63 : 15;
    if (DV == 256) { wlast = sample ? 32 : (2 * U.qb + 1 + (rg >> 1)); jd = -1; dq0 = 0; }
    else { jd = sample ? 32 : (1 + 4 * U.qb + (wid >> 1)); wlast = jd; dq0 = sample ? 32 * wid : 32 * (wid & 1); }
    const int qcol = (DV == 256) ? (U.h * 256 + map * 128) : U.h * 128;
    const int kcol = (DV == 256) ? U.h * 256 : U.h * 128, vcol = kcol;
    unsigned kofs[2], vofs[2];
#pragma unroll
    for (int i = 0; i < 2; ++i) {
        const int pi = 64 * (wid + 8 * i) + lane;
        const int row = pi >> 4, ch = (pi & 15) ^ (row & 7); kofs[i] = (unsigned)(row * 1024 + ch * 8) * 2u;
        const int sub = pi >> 5, rem = pi & 31, kk = (sub >> 2) * 8 + (rem >> 2), c = (sub & 3) * 32 + (rem & 3) * 8;
        const int k = (kk & ~0xC) | ((kk & 4) << 1) | ((kk & 8) >> 1); vofs[i] = (unsigned)(k * 1024 + c) * 2u;
    }
    const float* ck = nullptr; const float* cv = nullptr; bf16* dk = nullptr; bf16* dv = nullptr;
    if (sample) {
        const int sidx = (int)((U.srow0 - 33024) / 2112);
        ck = cacheK + (size_t)sidx * 2048 * 1024 + kcol; cv = cacheV + (size_t)sidx * 2048 * 1024 + vcol;
        dk = (bf16*)Kg + (size_t)U.srow0 * 1024 + kcol; dv = (bf16*)Vg + (size_t)U.srow0 * 1024 + vcol;
        const int tid = wid * 64 + lane;
        conv_tile<16 * NS, (2 * 64 * 16 * NS + 511) / 512>(ck, cv, dk, dv, 0, tid, 512);
        conv_tile<16 * NS, (2 * 64 * 16 * NS + 511) / 512>(ck, cv, dk, dv, 1, tid, 512);
        asm volatile("s_waitcnt vmcnt(0)" ::: "memory"); __builtin_amdgcn_s_barrier();
        __builtin_amdgcn_fence(__ATOMIC_ACQUIRE, "agent"); asm volatile("s_waitcnt vmcnt(0)" ::: "memory");
    }
    const char* kbase = (const char*)Kg + ((size_t)U.srow0 * 1024 + kcol) * 2;
    const char* vbase = (const char*)Vg + ((size_t)U.srow0 * 1024 + vcol) * 2;
    const float* cth = FOX ? cT + (size_t)U.h * 100608 + U.srow0 : nullptr;
#define A_ISSUE(j, s) do { const size_t _to = (size_t)(j) * (64 * 1024 * 2); \
        _Pragma("unroll") for (int _ks = 0; _ks < NS; ++_ks) _Pragma("unroll") for (int _i = 0; _i < 2; ++_i) \
            __builtin_amdgcn_global_load_lds((const unsigned*)(kbase + _to + _ks * 256 + kofs[_i]), (ALAS unsigned*)(lds + (s) * STAGE + _ks * 16384 + (wid + 8 * _i) * 1024), 16, 0, 0); \
        _Pragma("unroll") for (int _vs = 0; _vs < NS; ++_vs) _Pragma("unroll") for (int _i = 0; _i < 2; ++_i) \
            __builtin_amdgcn_global_load_lds((const unsigned*)(vbase + _to + _vs * 256 + vofs[_i]), (ALAS unsigned*)(lds + (s) * STAGE + (NS + _vs) * 16384 + (wid + 8 * _i) * 1024), 16, 0, 0); \
        if (FOX && wid == 0) __builtin_amdgcn_global_load_lds((const unsigned*)(cth + (j) * 64 + lane), (ALAS unsigned*)(lds + A_CK + (s) * 256), 4, 0, 0); } while (0)
    if (sample && !active) {
        constexpr int NCONV = (DV == 256) ? 4 : 6;
        const int cw = (DV == 256) ? ((wid >> 2) * 2 + (wid & 3) - 2) : (wid - 2), ct = cw * 64 + lane;
        A_ISSUE(0, 0);
        for (int j = 0; j < U.ntiles; ++j) {
            const int s = j & 1;
            asm volatile("s_waitcnt vmcnt(0)" ::: "memory"); __builtin_amdgcn_s_barrier(); asm volatile("" ::: "memory");
            if (j + 1 < U.ntiles) A_ISSUE(j + 1, s ^ 1);
            if (j + 2 < 32) conv_tile<16 * NS, (2 * 64 * 16 * NS + 64 * NCONV - 1) / (64 * NCONV)>(ck, cv, dk, dv, j + 2, ct, 64 * NCONV);
        }
        asm volatile("s_waitcnt vmcnt(0) lgkmcnt(0)" ::: "memory");
        __builtin_amdgcn_s_barrier();
        if constexpr (DV == 256) { __builtin_amdgcn_s_barrier(); __builtin_amdgcn_s_barrier(); }
        return;
    }
    bf16x8 qr[8];
    if (active) {
        const bf16* Qw = Qg + (size_t)(U.orow0 + rg * 32 + r32) * 1024 + qcol + hi * 8;
#pragma unroll
        for (int d0 = 0; d0 < 8; ++d0) qr[d0] = *(const bf16x8*)(Qw + d0 * 16);
    } else {
#pragma unroll
        for (int d0 = 0; d0 < 8; ++d0) qr[d0] = (bf16x8){0, 0, 0, 0, 0, 0, 0, 0};
    }
    float m_reg = -1e30f, l_reg = 0.f;
    f32x16 o[DV / 32];
#pragma unroll
    for (int d = 0; d < DV / 32; ++d) o[d] = (f32x16){};
    ALAS float* ws = (ALAS float*)(lds + A_WS) + wid * 64;
    const int vb0 = (int)(unsigned)(uintptr_t)(lds + NS * 16384) + v_rd_base(lane);
    int kx[4];
#pragma unroll
    for (int d = 0; d < 4; ++d) kx[d] = r32 * 256 + ((d * 32 + hi * 16) ^ ((r32 & 7) << 4));

    int j0 = 0;
    if (FOX && !sample) {
        const float ci0 = cth[64 + 256 * U.qb];
        int first = U.ntiles - 1;
        for (int base = 1; base < U.ntiles; base += 64) {
            const int jj = base + lane; bool ok = false;
            if (jj < U.ntiles) ok = (ci0 - cth[64 * jj + 63]) + prune_thr >= 0.f;
            const unsigned long long bm = __ballot(ok);
            if (bm) { first = base + (int)__builtin_ctzll(bm); break; }
        }
        first = __builtin_amdgcn_readfirstlane(first);
        j0 = (first <= 1) ? 0 : first;
    }
    if (wid < 4) __builtin_amdgcn_s_setprio(2);
    A_ISSUE(j0, j0 & 1);
    for (int j = j0; j < U.ntiles; ++j) {
        const int s = j & 1;
        asm volatile("s_waitcnt vmcnt(0)" ::: "memory"); __builtin_amdgcn_s_barrier(); asm volatile("" ::: "memory");
        if (j + 1 < U.ntiles) A_ISSUE(j + 1, s ^ 1);
        if (active && j <= wlast) {
            const ALAS char* Ks = (const ALAS char*)(lds + s * STAGE + map * 16384);
            f32x16 p0 = (f32x16){}, p1 = (f32x16){};
            {
                int ka[4];
#pragma unroll
                for (int i = 0; i < 4; ++i) ka[i] = (int)(unsigned)(uintptr_t)Ks + kx[i];
                bf16x8 k0a = lds_rd128<0>(ka[0]), k0b = lds_rd128<8192>(ka[0]);
                QkChain<0>::run(p0, p1, qr, ka, k0a, k0b);
            }
            if (FOX) {
                const ALAS float* ckp = (const ALAS float*)(lds + A_CK + s * 256) + 4 * hi;
#pragma unroll
                for (int g = 0; g < 4; ++g) {
                    const f32x4 c0 = *(const ALAS f32x4*)(ckp + 8 * g), c1 = *(const ALAS f32x4*)(ckp + 32 + 8 * g);
#pragma unroll
                    for (int i = 0; i < 4; ++i) { p0[4 * g + i] -= c0[i]; p1[4 * g + i] -= c1[i]; }
                }
            }
            if ((j == 0 && lim0 < 63) || j == jd) {
                int lim = 63; if (j == 0) lim = lim0; if (j == jd) { const int l2 = dq0 + r32; lim = l2 < lim ? l2 : lim; }
                const int limh = lim - 4 * hi;
                const float NEG = -__builtin_inff();
#pragma unroll
                for (int r = 0; r < 16; ++r) { const int cr = (r & 3) + 8 * (r >> 2); if (cr > limh) p0[r] = NEG; if (cr + 32 > limh) p1[r] = NEG; }
            }
            float pmax = p0[0];
#pragma unroll
            for (int r = 1; r < 16; ++r) pmax = fmaxf(pmax, p0[r]);
#pragma unroll
            for (int r = 0; r < 16; ++r) pmax = fmaxf(pmax, p1[r]);
            { auto rr = __builtin_amdgcn_permlane32_swap(__float_as_uint(pmax), __float_as_uint(pmax), false, false); pmax = fmaxf(__uint_as_float(rr[0]), __uint_as_float(rr[1])); }
            float mn, alpha;
            if (__all(pmax - m_reg <= THR2)) { mn = m_reg; alpha = 1.f; }
            else { mn = fmaxf(m_reg, pmax); alpha = __builtin_amdgcn_exp2f(m_reg - mn); m_reg = mn; }
#pragma unroll
            for (int r = 0; r < 16; ++r) { p0[r] = __builtin_amdgcn_exp2f(p0[r] - mn); p1[r] = __builtin_amdgcn_exp2f(p1[r] - mn); }
            if (__any(alpha < 1.f)) {
                if (hi == 0) ws[r32] = alpha;
                asm volatile("s_waitcnt lgkmcnt(0)" ::: "memory");
#pragma unroll
                for (int r = 0; r < 16; ++r) { const float a = ws[crow(r, hi)];
#pragma unroll
                    for (int d = 0; d < DV / 32; ++d) o[d][r] *= a; }
            }
            float ps = 0.f;
#pragma unroll
            for (int r = 0; r < 16; ++r) ps += p0[r] + p1[r];
            { auto rr = __builtin_amdgcn_permlane32_swap(__float_as_uint(ps), __float_as_uint(ps), false, false); ps = __uint_as_float(rr[0]) + __uint_as_float(rr[1]); }
            l_reg = l_reg * alpha + ps;
            bf16x8 pa0, pa1, pa2, pa3;
#define PK4(P, B_, OUT) do { unsigned a0 = cvtpk(P[B_ + 0], P[B_ + 1]), a1 = cvtpk(P[B_ + 2], P[B_ + 3]); unsigned b0_ = cvtpk(P[B_ + 4], P[B_ + 5]), b1_ = cvtpk(P[B_ + 6], P[B_ + 7]); \
        auto r0 = __builtin_amdgcn_permlane32_swap(a0, b0_, false, false); auto r1 = __builtin_amdgcn_permlane32_swap(a1, b1_, false, false); \
        u32x4 w = {r0[0], r1[0], r0[1], r1[1]}; OUT = *reinterpret_cast<bf16x8*>(&w); } while (0)
            PK4(p0, 0, pa0); PK4(p0, 8, pa1); PK4(p1, 0, pa2); PK4(p1, 8, pa3);
#undef PK4
            const int vb = vb0 + s * STAGE;
            pv_all<DV / 32>(o, vb, pa0, pa1, pa2, pa3);
        }
    }
#undef A_ISSUE
    __builtin_amdgcn_s_setprio(0);
    float rli[16];
    if (active) {
        if (hi == 0) ws[r32] = l_reg;
        asm volatile("s_waitcnt lgkmcnt(0)" ::: "memory");
#pragma unroll
        for (int r = 0; r < 16; ++r) rli[r] = __builtin_amdgcn_rcpf(ws[crow(r, hi)]);
    }
    asm volatile("s_waitcnt lgkmcnt(0)" ::: "memory"); __builtin_amdgcn_s_barrier(); asm volatile("" ::: "memory");
    if constexpr (DV == 256) {
        ALAS float* X = (ALAS float*)lds + (size_t)rg * (32 * 256);
        if (active && map == 1) {
            int xw = (4 * hi) * 256 + r32; asm volatile("" : "+v"(xw));
#pragma unroll
            for (int r = 0; r < 16; ++r)
#pragma unroll
                for (int d = 0; d < 8; ++d) X[xw + ((r & 3) + 8 * (r >> 2)) * 256 + d * 32] = o[d][r] * rli[r];
        }
        asm volatile("s_waitcnt lgkmcnt(0)" ::: "memory"); __builtin_amdgcn_s_barrier(); asm volatile("" ::: "memory");
        if (active && map == 0) {
            float ss[16];
            int xo = (4 * hi) * 256 + r32; asm volatile("" : "+v"(xo));
#pragma unroll
            for (int r = 0; r < 16; ++r) { float a = 0.f;
#pragma unroll
                for (int d = 0; d < 8; ++d) { const float v = o[d][r] * rli[r] - lam * X[xo + ((r & 3) + 8 * (r >> 2)) * 256 + d * 32]; o[d][r] = v; a += v * v; }
                ss[r] = a; }
#pragma unroll
            for (int r = 0; r < 16; ++r) { float a = ss[r]; a += __shfl_xor(a, 1); a += __shfl_xor(a, 2); a += __shfl_xor(a, 4); a += __shfl_xor(a, 8); a += __shfl_xor(a, 16);
                ss[r] = __builtin_amdgcn_rsqf(a * (1.0f / 256.0f) + 1e-6f) * 0.8f; }
            float gv[8];
            int go = r32; asm volatile("" : "+v"(go));
#pragma unroll
            for (int d = 0; d < 8; ++d) gv[d] = gout[go + d * 32];
            bf16* ob = merged + (size_t)(U.orow0 + rg * 32) * 2048 + U.h * 256;
            int oo = (4 * hi) * 2048 + r32; asm volatile("" : "+v"(oo));
#pragma unroll
            for (int r = 0; r < 16; ++r) { bf16* op = ob + (oo + ((r & 3) + 8 * (r >> 2)) * 2048);
#pragma unroll
                for (int d = 0; d < 8; ++d) op[d * 32] = (bf16)(cvtpk(o[d][r] * ss[r] * gv[d], 0.f) & 0xffffu); }
        }
        asm volatile("s_waitcnt lgkmcnt(0)" ::: "memory"); __builtin_amdgcn_s_barrier(); asm volatile("" ::: "memory");
    } else {
        if (active) {
            float ss[16];
#pragma unroll
            for (int r = 0; r < 16; ++r) { float a = 0.f;
#pragma unroll
                for (int d = 0; d < 4; ++d) { const float v = o[d][r] * rli[r]; o[d][r] = v; a += v * v; }
                ss[r] = a; }
#pragma unroll
            for (int r = 0; r < 16; ++r) { float a = ss[r]; a += __shfl_xor(a, 1); a += __shfl_xor(a, 2); a += __shfl_xor(a, 4); a += __shfl_xor(a, 8); a += __shfl_xor(a, 16);
                ss[r] = __builtin_amdgcn_rsqf(a * (1.0f / 128.0f) + 1e-6f); }
            float gv[4];
            int go = r32; asm volatile("" : "+v"(go));
#pragma unroll
            for (int d = 0; d < 4; ++d) gv[d] = gout[go + d * 32];
            bf16* ob = merged + (size_t)(U.orow0 + rg * 32) * 2048 + 1024 + U.h * 128;
            int oo = (4 * hi) * 2048 + r32; asm volatile("" : "+v"(oo));
#pragma unroll
            for (int r = 0; r < 16; ++r) { bf16* op = ob + (oo + ((r & 3) + 8 * (r >> 2)) * 2048);
#pragma unroll
                for (int d = 0; d < 4; ++d) op[d * 32] = (bf16)(cvtpk(o[d][r] * ss[r] * gv[d], 0.f) & 0xffffu); }
        }
    }
}


typedef float f32x4a __attribute__((ext_vector_type(4)));
__device__ __forceinline__ float xr16_max(float v) { auto r = __builtin_amdgcn_permlane16_swap(__float_as_uint(v), __float_as_uint(v), false, false); v = fmaxf(__uint_as_float(r[0]), __uint_as_float(r[1]));
    auto q = __builtin_amdgcn_permlane32_swap(__float_as_uint(v), __float_as_uint(v), false, false); return fmaxf(__uint_as_float(q[0]), __uint_as_float(q[1])); }
__device__ __forceinline__ float xr16_sum(float v) { auto r = __builtin_amdgcn_permlane16_swap(__float_as_uint(v), __float_as_uint(v), false, false); v = __uint_as_float(r[0]) + __uint_as_float(r[1]);
    auto q = __builtin_amdgcn_permlane32_swap(__float_as_uint(v), __float_as_uint(v), false, false); return __uint_as_float(q[0]) + __uint_as_float(q[1]); }
template <int I> struct Qk16 {
    static __device__ __forceinline__ void run(f32x4a (&sc)[2][4], const bf16x8 (&qf)[2][4], const int (&ka)[4], bf16x8 cur) {
        bf16x8 nxt;
        if constexpr (I < 15) { nxt = lds_rd128<((I + 1) & 3) * 4096>(ka[(I + 1) >> 2]); asm volatile("s_waitcnt lgkmcnt(1)" ::: "memory"); }
        else { asm volatile("s_waitcnt lgkmcnt(0)" ::: "memory"); }
        ASBAR();
        constexpr int ks = I >> 2, t = I & 3;
        sc[0][t] = __builtin_amdgcn_mfma_f32_16x16x32_bf16(cur, qf[0][ks], sc[0][t], 0, 0, 0);
        sc[1][t] = __builtin_amdgcn_mfma_f32_16x16x32_bf16(cur, qf[1][ks], sc[1][t], 0, 0, 0);
        ASBAR();
        if constexpr (I < 15) Qk16<I + 1>::run(sc, qf, ka, nxt);
    }
};
template <int DT> __device__ __forceinline__ void tr4(s16x4 (&f)[4], int vb) {
    constexpr int b = (DT >> 3) * 16384 + ((DT & 7) >> 1) * 512;
    f[0] = tr_read<b>(vb); f[1] = tr_read<b + 4096>(vb); f[2] = tr_read<b + 8192>(vb); f[3] = tr_read<b + 8192 + 4096>(vb);
}
template <int DT> struct Pv16 {
    static __device__ __forceinline__ void run(f32x4a (&o)[2][16], int ve, int vo, s16x4 (&cur)[4], const bf16x8 (&pb)[2][2]) {
        s16x4 nxt[4];
        if constexpr (DT < 15) { tr4<DT + 1>(nxt, ((DT + 1) & 1) ? vo : ve); asm volatile("s_waitcnt lgkmcnt(4)" ::: "memory"); }
        else { asm volatile("s_waitcnt lgkmcnt(0)" ::: "memory"); }
        ASBAR();
        const bf16x8 va0 = (bf16x8){cur[0][0], cur[0][1], cur[0][2], cur[0][3], cur[1][0], cur[1][1], cur[1][2], cur[1][3]};
        const bf16x8 va1 = (bf16x8){cur[2][0], cur[2][1], cur[2][2], cur[2][3], cur[3][0], cur[3][1], cur[3][2], cur[3][3]};
        o[0][DT] = __builtin_amdgcn_mfma_f32_16x16x32_bf16(va0, pb[0][0], o[0][DT], 0, 0, 0);
        o[1][DT] = __builtin_amdgcn_mfma_f32_16x16x32_bf16(va0, pb[1][0], o[1][DT], 0, 0, 0);
        o[0][DT] = __builtin_amdgcn_mfma_f32_16x16x32_bf16(va1, pb[0][1], o[0][DT], 0, 0, 0);
        o[1][DT] = __builtin_amdgcn_mfma_f32_16x16x32_bf16(va1, pb[1][1], o[1][DT], 0, 0, 0);
        ASBAR();
        if constexpr (DT < 15) Pv16<DT + 1>::run(o, ve, vo, nxt, pb);
    }
};

__device__ __forceinline__ void attn_unit_a16(ALAS unsigned char* lds, const UnitP U, const bf16* __restrict__ Qg, const bf16* __restrict__ Kg, const bf16* __restrict__ Vg,
                                              const float* __restrict__ gout, float lam, bf16* __restrict__ merged, const float* __restrict__ cacheK, const float* __restrict__ cacheV, int wid, int lane) {
    constexpr int NS = 2, STAGE = 65536;
    asm volatile("" : "+v"(lane));
    const int c = lane & 15, g = lane >> 4;
    const bool sample = U.kind >= 2;
    const int rg = wid & 3, map = wid >> 2;
    const bool active = sample ? (rg < 2) : true;
    const int wlast = sample ? 32 : (2 * U.qb + 1 + (rg >> 1)); const int lim0 = sample ? 63 : 15;
    const int qcol = U.h * 256 + map * 128, kcol = U.h * 256, vcol = kcol;
    unsigned kofs[2], vofs[2];
#pragma unroll
    for (int i = 0; i < 2; ++i) {
        const int pi = 64 * (wid + 8 * i) + lane;
        const int row = pi >> 4, ch = (pi & 15) ^ (row & 15); kofs[i] = (unsigned)(row * 1024 + ch * 8) * 2u;
        const int sub = pi >> 5, rem = pi & 31, kk = (sub >> 2) * 8 + (rem >> 2), cc = (sub & 3) * 32 + ((rem & 3) ^ (((sub >> 2) & 1) << 1)) * 8;
        const int k = (kk & ~0xC) | ((kk & 4) << 1) | ((kk & 8) >> 1); vofs[i] = (unsigned)(k * 1024 + cc) * 2u;
    }
    if (sample) {
        const int sidx = (int)((U.srow0 - 33024) / 2112);
        const float* ck = cacheK + (size_t)sidx * 2048 * 1024 + kcol; const float* cv = cacheV + (size_t)sidx * 2048 * 1024 + vcol;
        bf16* dk = (bf16*)Kg + (size_t)U.srow0 * 1024 + kcol; bf16* dv = (bf16*)Vg + (size_t)U.srow0 * 1024 + vcol;
        constexpr int PR = 16 * NS, NP = 2048 * PR;
        const int tid = wid * 64 + lane;
        for (int p0 = tid; p0 < 2 * NP; p0 += 512 * 8) {
            f32x4 x[16];
#pragma unroll
            for (int u = 0; u < 8; ++u) { const int p = p0 + u * 512; const int q = p & (NP - 1); const float* src = ((p < NP) ? ck : cv) + (size_t)(q / PR) * 1024 + (q % PR) * 8;
                x[2 * u] = *(const f32x4*)src; x[2 * u + 1] = *(const f32x4*)(src + 4); }
#pragma unroll
            for (int u = 0; u < 8; ++u) { const int p = p0 + u * 512; const int q = p & (NP - 1); bf16* dst = ((p < NP) ? dk : dv) + (size_t)(q / PR) * 1024 + (q % PR) * 8;
                u32x4 w = {cvtpk(x[2 * u][0], x[2 * u][1]), cvtpk(x[2 * u][2], x[2 * u][3]), cvtpk(x[2 * u + 1][0], x[2 * u + 1][1]), cvtpk(x[2 * u + 1][2], x[2 * u + 1][3])};
                *(u32x4*)dst = w; }
        }
        asm volatile("s_waitcnt vmcnt(0)" ::: "memory"); __builtin_amdgcn_s_barrier();
        __builtin_amdgcn_fence(__ATOMIC_ACQUIRE, "agent"); asm volatile("s_waitcnt vmcnt(0)" ::: "memory");
    }
    const char* kbase = (const char*)Kg + ((size_t)U.srow0 * 1024 + kcol) * 2;
    const char* vbase = (const char*)Vg + ((size_t)U.srow0 * 1024 + vcol) * 2;
#define A16_ISSUE(j, s) do { const size_t _to = (size_t)(j) * (64 * 1024 * 2); \
        _Pragma("unroll") for (int _ks = 0; _ks < NS; ++_ks) _Pragma("unroll") for (int _i = 0; _i < 2; ++_i) \
            __builtin_amdgcn_global_load_lds((const unsigned*)(kbase + _to + _ks * 256 + kofs[_i]), (ALAS unsigned*)(lds + (s) * STAGE + _ks * 16384 + (wid + 8 * _i) * 1024), 16, 0, 0); \
        _Pragma("unroll") for (int _vs = 0; _vs < NS; ++_vs) _Pragma("unroll") for (int _i = 0; _i < 2; ++_i) \
            __builtin_amdgcn_global_load_lds((const unsigned*)(vbase + _to + _vs * 256 + vofs[_i]), (ALAS unsigned*)(lds + (s) * STAGE + (NS + _vs) * 16384 + (wid + 8 * _i) * 1024), 16, 0, 0); } while (0)
    bf16x8 qf[2][4];
    if (active) {
#pragma unroll
        for (int a = 0; a < 2; ++a) { const bf16* Qw = Qg + (size_t)(U.orow0 + rg * 32 + 16 * a + c) * 1024 + qcol + 8 * g;
#pragma unroll
            for (int ks = 0; ks < 4; ++ks) qf[a][ks] = *(const bf16x8*)(Qw + 32 * ks); }
    } else {
#pragma unroll
        for (int a = 0; a < 2; ++a)
#pragma unroll
            for (int ks = 0; ks < 4; ++ks) qf[a][ks] = (bf16x8){0, 0, 0, 0, 0, 0, 0, 0};
    }
    float m_reg[2] = {-1e30f, -1e30f}, l_reg[2] = {0.f, 0.f};
    f32x4a o[2][16];
#pragma unroll
    for (int a = 0; a < 2; ++a)
#pragma unroll
        for (int d = 0; d < 16; ++d) o[a][d] = (f32x4a){0.f, 0.f, 0.f, 0.f};
    int kx[4];
#pragma unroll
    for (int ks = 0; ks < 4; ++ks) kx[ks] = c * 256 + ((64 * ks + 16 * g) ^ (c << 4));
    const int vbl = (int)(unsigned)(uintptr_t)(lds + NS * 16384) + (g & 1) * 2048 + (g >> 1) * 256 + (c >> 2) * 64;
    const int vbE = vbl + (((c & 3) * 8) ^ ((g & 1) << 5)), vbO = vbl + ((32 + (c & 3) * 8) ^ ((g & 1) << 5));

    A16_ISSUE(0, 0);
    for (int j = 0; j < U.ntiles; ++j) {
        const int s = j & 1;
        asm volatile("s_waitcnt vmcnt(0)" ::: "memory"); __builtin_amdgcn_s_barrier(); asm volatile("" ::: "memory");
        if (j + 1 < U.ntiles) A16_ISSUE(j + 1, s ^ 1);
        if (active && j <= wlast) {
            f32x4a sc[2][4];
#pragma unroll
            for (int a = 0; a < 2; ++a)
#pragma unroll
                for (int t = 0; t < 4; ++t) sc[a][t] = (f32x4a){0.f, 0.f, 0.f, 0.f};
            {
                const int Ks = (int)(unsigned)(uintptr_t)(lds + s * STAGE + map * 16384);
                int ka[4];
#pragma unroll
                for (int i = 0; i < 4; ++i) ka[i] = Ks + kx[i];
                bf16x8 k0 = lds_rd128<0>(ka[0]);
                Qk16<0>::run(sc, qf, ka, k0);
            }
            if (j == 0 && lim0 < 63) {
                const float NEG = -__builtin_inff();
#pragma unroll
                for (int a = 0; a < 2; ++a)
#pragma unroll
                    for (int t = 1; t < 4; ++t) sc[a][t] = (f32x4a){NEG, NEG, NEG, NEG};
            }
            float pm[2], al[2] = {1.f, 1.f}, mn[2];
#pragma unroll
            for (int a = 0; a < 2; ++a) { float v = sc[a][0][0];
#pragma unroll
                for (int t = 0; t < 4; ++t)
#pragma unroll
                    for (int r = 0; r < 4; ++r) v = fmaxf(v, sc[a][t][r]);
                pm[a] = xr16_max(v); }
            if (__all((pm[0] - m_reg[0] <= THR2) && (pm[1] - m_reg[1] <= THR2))) { mn[0] = m_reg[0]; mn[1] = m_reg[1]; }
            else {
#pragma unroll
                for (int a = 0; a < 2; ++a) { mn[a] = fmaxf(m_reg[a], pm[a]); al[a] = __builtin_amdgcn_exp2f(m_reg[a] - mn[a]); m_reg[a] = mn[a]; }
                if (__any(al[0] < 1.f || al[1] < 1.f)) {
#pragma unroll
                    for (int a = 0; a < 2; ++a)
#pragma unroll
                        for (int d = 0; d < 16; ++d) o[a][d] = o[a][d] * al[a];
                }
            }
            bf16x8 pb[2][2];
#pragma unroll
            for (int a = 0; a < 2; ++a) { float ps = 0.f;
#pragma unroll
                for (int t = 0; t < 4; ++t)
#pragma unroll
                    for (int r = 0; r < 4; ++r) { const float e = __builtin_amdgcn_exp2f(sc[a][t][r] - mn[a]); sc[a][t][r] = e; ps += e; }
                l_reg[a] = l_reg[a] * al[a] + xr16_sum(ps);
#pragma unroll
                for (int s2 = 0; s2 < 2; ++s2) { u32x4 w = {cvtpk(sc[a][2 * s2][0], sc[a][2 * s2][1]), cvtpk(sc[a][2 * s2][2], sc[a][2 * s2][3]), cvtpk(sc[a][2 * s2 + 1][0], sc[a][2 * s2 + 1][1]), cvtpk(sc[a][2 * s2 + 1][2], sc[a][2 * s2 + 1][3])};
                    pb[a][s2] = *reinterpret_cast<bf16x8*>(&w); } }
            { const int ve = vbE + s * STAGE, vo = vbO + s * STAGE; s16x4 f0[4]; tr4<0>(f0, ve); Pv16<0>::run(o, ve, vo, f0, pb); }
        }
    }
#undef A16_ISSUE
    asm volatile("s_waitcnt lgkmcnt(0)" ::: "memory"); __builtin_amdgcn_s_barrier(); asm volatile("" ::: "memory");
    ALAS float* X = (ALAS float*)lds + (size_t)rg * (32 * 256);
    int xo = c * 256 + 4 * g; asm volatile("" : "+v"(xo));
    if (active && map == 1) {
#pragma unroll
        for (int a = 0; a < 2; ++a) { const float rl = __builtin_amdgcn_rcpf(l_reg[a]);
#pragma unroll
            for (int d = 0; d < 16; ++d) *(ALAS f32x4a*)(X + xo + a * 16 * 256 + d * 16) = o[a][d] * rl; }
    }
    asm volatile("s_waitcnt lgkmcnt(0)" ::: "memory"); __builtin_amdgcn_s_barrier(); asm volatile("" ::: "memory");
    if (active && map == 0) {
        int go = 4 * g; asm volatile("" : "+v"(go));
        bf16* ob = merged + (size_t)(U.orow0 + rg * 32) * 2048 + U.h * 256;
        int oo = c * 2048 + 4 * g; asm volatile("" : "+v"(oo));
#pragma unroll
        for (int a = 0; a < 2; ++a) { const float rl = __builtin_amdgcn_rcpf(l_reg[a]); float ss = 0.f;
#pragma unroll
            for (int d = 0; d < 16; ++d) { const f32x4a x2 = *(const ALAS f32x4a*)(X + xo + a * 16 * 256 + d * 16); const f32x4a v = o[a][d] * rl - x2 * lam; o[a][d] = v;
                ss += (v[0] * v[0] + v[1] * v[1]) + (v[2] * v[2] + v[3] * v[3]); }
            const float rs = __builtin_amdgcn_rsqf(xr16_sum(ss) * (1.0f / 256.0f) + 1e-6f) * 0.8f;
#pragma unroll
            for (int d = 0; d < 16; ++d) { const f32x4a gv = *(const f32x4a*)(gout + go + d * 16); const f32x4a v = o[a][d] * rs * gv;
                typedef unsigned u32x2a __attribute__((ext_vector_type(2)));
                u32x2a w; w.x = cvtpk(v[0], v[1]); w.y = cvtpk(v[2], v[3]);
                *(u32x2a*)(ob + oo + a * 16 * 2048 + d * 16) = w; } }
    }
    asm volatile("s_waitcnt lgkmcnt(0)" ::: "memory"); __builtin_amdgcn_s_barrier(); asm volatile("" ::: "memory");
}

constexpr int N_Q_UNITS = 94 + 16 + 16 + 32 + 18 + 128;
__device__ __forceinline__ bool decode_unit(int q, int w, UnitP& U) {
    auto Ap = [&](int L, int bh) { U.kind = 0; U.qb = L; const int b = bh >> 2; U.h = bh & 3; U.orow0 = (long)b * 8192 + 128 * L; U.srow0 = (long)b * 8256; U.ntiles = 2 * L + 3; };
    auto Bp = [&](int L, int bh) { U.kind = 1; U.qb = L; const int b = bh >> 3; U.h = bh & 7; U.orow0 = (long)b * 8192 + 256 * L; U.srow0 = (long)b * 8256; U.ntiles = 4 * L + 5; };
    auto As = [&](int i) { U.kind = 2; U.qb = 0; const int s = i >> 2; U.h = i & 3; U.orow0 = 32768 + 64 * s; U.srow0 = 33024 + (long)s * 2112; U.ntiles = 33; };
    auto Bs = [&](int i) { U.kind = 3; U.qb = 0; const int s = i >> 3; U.h = i & 7; U.orow0 = 32768 + 64 * s; U.srow0 = 33024 + (long)s * 2112; U.ntiles = 33; };
    if (w < 94) { Ap(63 - (w >> 1), 2 * q + (w & 1)); return true; } w -= 94;
    if (w < 16) { As(16 * q + w); return true; } w -= 16;
    if (w < 16) { Ap(16 - (w >> 1), 2 * q + (w & 1)); return true; } w -= 16;
    if (w < 32) { Bs(32 * q + w); return true; } w -= 32;
    if (w < 18) { Ap(8 - (w >> 1), 2 * q + (w & 1)); return true; } w -= 18;
    if (w < 128) { Bp(31 - (w >> 2), 4 * q + (w & 3)); return true; }
    return false;
}
}

constexpr int DM = 2048, FF = 5632, NIN = 6152, NQKV = 6144;
constexpr int MA = 34816;
constexpr int M1 = 35072;
constexpr int SEQP = 8208, PSTR = 8256, SSTR = 2112, SROW_S0 = 4 * PSTR, NSR = SROW_S0 + 32 * SSTR;
constexpr size_t O_YP = 0, O_YS = O_YP + (size_t)4 * 8192 * 2048, O_AKP = O_YS + (size_t)32 * 64 * 2048, O_AVP = O_AKP + (size_t)4 * SEQP * 1024, O_BKP = O_AVP + (size_t)4 * SEQP * 1024,
                 O_BVP = O_BKP + (size_t)4 * SEQP * 1024, O_LFP = O_BVP + (size_t)4 * SEQP * 1024, O_AKS = O_LFP + (size_t)4 * SEQP * 8, O_AVS = O_AKS + (size_t)2048 * 1024,
                 O_BKS = O_AVS + (size_t)2048 * 1024, O_BVS = O_BKS + (size_t)2048 * 1024, O_LFS = O_BVS + (size_t)2048 * 1024, O_END = O_LFS + (size_t)2048 * 8;
constexpr size_t MiB = 1u << 20;
constexpr size_t WS_CTL = 0, CTL_ZERO_BYTES = 1 * MiB;
constexpr size_t WS_W13A = 1 * MiB, WS_W13B = WS_W13A + 44 * MiB, WS_W2A = WS_W13B + 44 * MiB, WS_W2B = WS_W2A + 22 * MiB, WS_WIN = WS_W2B + 22 * MiB, WS_WO = WS_WIN + 24 * MiB;
constexpr size_t WS_WF = WS_WO + 8 * MiB, WS_ROPE = WS_WF + 1 * MiB, WS_CT = WS_ROPE + 2 * MiB, WS_RESID = WS_CT + 4 * MiB;
constexpr size_t WS_XN = WS_RESID + 274 * MiB, WS_QA = WS_XN + 137 * MiB, WS_QB = WS_QA + 68 * MiB, WS_KA = WS_QB + 68 * MiB;
constexpr size_t SBUF = (size_t)NSR * 1024 * 2;
constexpr size_t WS_VA = WS_KA + SBUF, WS_KB = WS_VA + SBUF, WS_VB = WS_KB + SBUF, WS_END = WS_VB + SBUF;
constexpr size_t WS_SLAB = WS_KB + 66 * MiB;
constexpr size_t WS_H = WS_QA;
constexpr size_t WS_XN2 = WS_QA, WS_H2 = WS_KA;
constexpr size_t WS_FGP = WS_W13A, WS_SSQ1 = WS_W13A + 40 * MiB, WS_SSQ2 = WS_W13A + 42 * MiB;
constexpr size_t WS_WFB = WS_WF + 256 * 1024;
static_assert((size_t)MA * DM * 2 <= 136 * MiB && WS_H2 + (size_t)MA * FF * 2 <= WS_KB && (size_t)32 * M1 * 8 * 4 <= 40 * MiB && (size_t)8 * M1 * 4 <= 2 * MiB && WS_SSQ2 + 2 * MiB <= WS_W13B, "d_ws map");
static_assert((size_t)M1 * DM * 4 <= 274 * MiB && (size_t)M1 * DM * 2 <= 137 * MiB && (size_t)MA * 1024 * 2 <= 68 * MiB && WS_H + (size_t)M1 * FF * 2 <= WS_END, "d_ws map");
static_assert((size_t)8208 * 32 * 4 <= 2 * MiB && (size_t)8 * NSR * 4 <= 4 * MiB, "d_ws map");
constexpr int CW_TMO = 0, CW_QUEUE = 1024, CW_LAM = 128, CW_PRUNE = 136, CW_SBA = 144, CW_CQ0 = 2048, CW_CQ1 = 2112, CW_CQ2 = 2176, CW_XRANK = 2560, CW_DYN = 3072, CW_BAR = 4096;
constexpr int LDS_RING = 0, LDS_CTL = 131072, LDS_SCR = 131072 + 256, LDS_RT = 131072 + 256 + 8192 + 2048 + 256, LDS_BYTES = LDS_RT + 14 * 1024;
static_assert(LDS_SCR + 24 * 1024 <= LDS_BYTES && LDS_BYTES <= 160 * 1024, "LDS map");
static_assert(att::A_WS == LDS_SCR && att::A_QW == LDS_CTL + 16, "LDS map");

#define GAS __attribute__((address_space(1)))
#define LAS __attribute__((address_space(3)))
typedef unsigned short bf16;
typedef unsigned v4u __attribute__((ext_vector_type(4)));
typedef unsigned v2u __attribute__((ext_vector_type(2)));
typedef float f32x4 __attribute__((ext_vector_type(4)));
#define RLX_AGENT __ATOMIC_RELAXED, __HIP_MEMORY_SCOPE_AGENT
#define LDS_WAIT() asm volatile("s_waitcnt lgkmcnt(0)" ::: "memory")
__device__ __forceinline__ unsigned f2bf(float f) { unsigned u = __builtin_bit_cast(unsigned, f); return (u + 0x7fffu + ((u >> 16) & 1u)) >> 16; }
__device__ __forceinline__ unsigned pk2(float lo, float hi) { return f2bf(lo) | (f2bf(hi) << 16); }
__device__ __forceinline__ float wave_sum(float v) {
#pragma unroll
    for (int o = 1; o < 64; o <<= 1) v += __shfl_xor(v, o);
    return v;
}
#define XB_TMO      128
#define XB_XCNT(j)  (256  + 64 * (j))
#define XB_XSUB(j)  (1280 + 64 * (j))
#define XB_XGEN(j)  (2304 + 64 * (j))
#define XB_TOP      3328
#define XB_TOPGEN   3392
#define XCD_BAR_WORDS 3456
#define XB_SPIN_CAP (1u << 18)

__device__ __forceinline__ unsigned xb_ld(unsigned* p)              { return __hip_atomic_load(p, __ATOMIC_RELAXED, __HIP_MEMORY_SCOPE_AGENT); }
__device__ __forceinline__ unsigned xb_add(unsigned* p, unsigned v) { return __hip_atomic_fetch_add(p, v, __ATOMIC_RELAXED, __HIP_MEMORY_SCOPE_AGENT); }
__device__ __forceinline__ unsigned xb_xcc_id() { return (unsigned)__builtin_amdgcn_s_getreg((3 << 11) | 20) & 0xFu; }
#define XB_SPIN(cond, bar) do { unsigned _sp = 0; while (cond) { __builtin_amdgcn_s_sleep(1); \
    if ((++_sp & 255u) == 0u) { if (xb_ld(&(bar)[XB_TMO])) break; if (_sp > XB_SPIN_CAP) { atomicAdd(&(bar)[XB_TMO], 1u); break; } } } } while (0)

struct XcdBarrier {
    unsigned* bar; unsigned x;
    volatile LAS unsigned* st;
};

__device__ __forceinline__ XcdBarrier xcd_barrier_post(unsigned* bar, volatile LAS unsigned* st) {
    XcdBarrier b; b.bar = bar; b.x = xb_xcc_id(); b.st = st;
    if (threadIdx.x == 0) (void)xb_add(&bar[XB_XCNT(b.x)], 1u);
    return b;
}
__device__ __forceinline__ void xcd_barrier_complete(unsigned* bar, unsigned x, unsigned& nloc, unsigned& nx) {
    const unsigned G = gridDim.x * gridDim.y * gridDim.z;
    unsigned sum, cnt, mine, sp = 0u;
    for (;;) {
        sum = 0u; cnt = 0u; mine = 0u;
#pragma unroll
        for (unsigned j = 0; j < 16; ++j) { const unsigned c = xb_ld(&bar[XB_XCNT(j)]); sum += c; cnt += (c > 0u) ? 1u : 0u; mine = (j == x) ? c : mine; }
        if (sum == G) break;
        __builtin_amdgcn_s_sleep(1);
        if ((++sp & 255u) == 0u) { if (xb_ld(&bar[XB_TMO])) break; if (sp > XB_SPIN_CAP) { atomicAdd(&bar[XB_TMO], 1u); break; } }
    }
    nloc = mine > 0u ? mine : 1u; nx = cnt > 0u ? cnt : 1u;
}

__device__ __forceinline__ void xcd_barrier(const XcdBarrier& b) {
    asm volatile("s_waitcnt vmcnt(0)" ::: "memory");
    __syncthreads();
    if (threadIdx.x == 0) {
        unsigned* bar = b.bar;
        __builtin_amdgcn_s_waitcnt(0);
        unsigned nloc = b.st[0], nx = b.st[1];
        if (nloc == 0u) { xcd_barrier_complete(bar, b.x, nloc, nx); b.st[0] = nloc; b.st[1] = nx; }
        const unsigned old = xb_add(&bar[XB_XSUB(b.x)], 1u);
        const unsigned gen = old / nloc;
        if (old + 1u == (gen + 1u) * nloc) {
            __builtin_amdgcn_fence(__ATOMIC_RELEASE, "agent");
            asm volatile("s_waitcnt vmcnt(0)" ::: "memory");
            const unsigned og = xb_add(&bar[XB_TOP], 1u);
            const unsigned tg = og / nx;
            if (og + 1u == (tg + 1u) * nx) xb_add(&bar[XB_TOPGEN], 1u);
            else XB_SPIN(xb_ld(&bar[XB_TOPGEN]) == tg, bar);
            __builtin_amdgcn_fence(__ATOMIC_ACQUIRE, "agent");
            xb_add(&bar[XB_XGEN(b.x)], 1u);
            asm volatile("s_waitcnt vmcnt(0)" ::: "memory");
        } else {
            XB_SPIN(xb_ld(&bar[XB_XGEN(b.x)]) == gen, bar);
            __builtin_amdgcn_fence(__ATOMIC_ACQUIRE, "agent");
            asm volatile("s_waitcnt vmcnt(0)" ::: "memory");
        }
    }
    __syncthreads();
}

struct Args { const float* in[31]; float* out; unsigned char* ws; int ph_lo, ph_hi, li, pad; };
constexpr int N_PHASES = 11;
enum { I_XP = 0, I_XS, I_CAK, I_CAV, I_CBK, I_CBV, I_CLF, I_META, I_GF1, I_F1W1, I_F1W3, I_F1W2, I_GMIX, I_WIN, I_BF, I_GQA, I_GKA, I_GQB, I_GKB, I_LQ1, I_LK1, I_LQ2, I_LK2, I_GOA, I_GOB, I_WOUT, I_GF2, I_F2W1, I_F2W3, I_F2W2, I_GFIN };

__device__ __forceinline__ void transpose_item(const float* W, int ldw, int K, bf16* WT, int k0, int n0, int out_row0, LAS float* scr, int lane, const float* gk = nullptr) {
#pragma unroll 8
    for (int i = 0; i < 32; ++i) { const int kk = 2 * i + (lane >> 5); float w = W[(size_t)(k0 + kk) * ldw + n0 + (lane & 31)]; if (gk) w *= gk[k0 + kk]; scr[kk * 33 + (lane & 31)] = w; }
    LDS_WAIT(); asm volatile("" ::: "memory");
    const int c = lane & 7;
#pragma unroll
    for (int j = 0; j < 4; ++j) { const int n = (lane >> 3) + 8 * j; const LAS float* s = scr + (8 * c) * 33 + n;
        v4u o; o.x = pk2(s[0 * 33], s[1 * 33]); o.y = pk2(s[2 * 33], s[3 * 33]); o.z = pk2(s[4 * 33], s[5 * 33]); o.w = pk2(s[6 * 33], s[7 * 33]);
        *(GAS v4u*)(WT + (size_t)(out_row0 + n) * K + k0 + 8 * c) = o; }
    LDS_WAIT(); asm volatile("" ::: "memory");
}
__device__ __forceinline__ float rms_load(const float* xrow, int lane, f32x4 (&v)[8]) {
    const GAS f32x4* xr = (const GAS f32x4*)xrow + lane; float s = 0.f;
#pragma unroll
    for (int j = 0; j < 8; ++j) { v[j] = xr[64 * j]; s += (v[j].x * v[j].x + v[j].y * v[j].y) + (v[j].z * v[j].z + v[j].w * v[j].w); }
    return __builtin_amdgcn_rsqf(wave_sum(s) * (1.0f / 2048.0f) + 1e-6f);
}
__device__ __forceinline__ void store_row_bf16(bf16* orow, int lane, const f32x4 (&v)[8]) {
    GAS v2u* o8 = (GAS v2u*)orow + lane;
#pragma unroll
    for (int j = 0; j < 8; ++j) { v2u w; w.x = pk2(v[j].x, v[j].y); w.y = pk2(v[j].z, v[j].w); o8[64 * j] = w; }
}
__device__ __forceinline__ const float* in_row(const Args& a, int R) {
    return (R < 32768) ? a.in[I_XP] + (size_t)R * DM : (R < 34816) ? a.in[I_XS] + (size_t)(R - 32768) * DM : (R < 34832) ? a.in[I_META] + (size_t)(R - 34816) * DM : nullptr;
}

__device__ __forceinline__ void build_tail_table(LAS unsigned short* tab, int M, int G, int tid) {
    pg8::TailOrder T; T.init(M, DM, G, 0, 1, 0);
    for (int i = tid; i < (M / 256) * 8; i += 512) tab[i] = 0;
    __syncthreads();
    for (int t = tid; t < T.nitems; t += 512) { pg8::Unit u; T.S.decode(T.base + t, u); tab[u.pm * 8 + u.pn] = (unsigned short)(t + 1); }
    __syncthreads();
}
template <int MODE>
__device__ __forceinline__ bool tail_fix(f32x4 (&v)[8], const LAS unsigned short* tab, const float* slabs, int R, int lane, float alpha, const float* xin) {
    const v4u tq = *(const LAS v4u*)(tab + (R >> 8) * 8);
    if ((tq.x | tq.y | tq.z | tq.w) == 0u) return false;
    const unsigned tw[4] = {tq.x, tq.y, tq.z, tq.w};
#pragma unroll
    for (int j = 0; j < 8; ++j) {
        const unsigned slot = (tw[j >> 1] >> (16 * (j & 1))) & 0xffffu;
        if (slot) {
            const GAS f32x4* sp = (const GAS f32x4*)(slabs + (size_t)(slot - 1) * 4 * 65536 + (size_t)(R & 255) * 256) + lane;
            const f32x4 s = (sp[0] + sp[16384]) + (sp[2 * 16384] + sp[3 * 16384]);
            f32x4 b = v[j];
            if (MODE == 1) b = xin ? ((const GAS f32x4*)xin)[64 * j + lane] : (f32x4){0.f, 0.f, 0.f, 0.f};
            v[j] = b + s * alpha;
        }
    }
    return true;
}
__device__ __forceinline__ void row_load(const float* xrow, int lane, f32x4 (&v)[8]) {
    const GAS f32x4* xr = (const GAS f32x4*)xrow + lane;
#pragma unroll
    for (int j = 0; j < 8; ++j) v[j] = xr[64 * j];
}
__device__ __forceinline__ void row_store(float* xrow, int lane, const f32x4 (&v)[8]) {
    GAS f32x4* xr = (GAS f32x4*)xrow + lane;
#pragma unroll
    for (int j = 0; j < 8; ++j) xr[64 * j] = v[j];
}
__device__ __forceinline__ float row_rstd(const f32x4 (&v)[8]) {
    float s = 0.f;
#pragma unroll
    for (int j = 0; j < 8; ++j) s += (v[j].x * v[j].x + v[j].y * v[j].y) + (v[j].z * v[j].z + v[j].w * v[j].w);
    return __builtin_amdgcn_rsqf(wave_sum(s) * (1.0f / 2048.0f) + 1e-6f);
}
constexpr int CV_I13 = 32 * 176, CV_I2 = 88 * 64, CV_IIN = 32 * 192, CV_IO = 32 * 64, CV_N = 4 * CV_I13 + 2 * CV_I2 + CV_IIN + CV_IO;
#define CONV_ITEM(itx) do { int r_ = (itx); LAS float* scr_ = (LAS float*)(lds + LDS_RING + wid * 16384); \
        if (r_ < 4 * CV_I13) { const int which = r_ / CV_I13; r_ -= which * CV_I13; const int kb = r_ / 176, nb = r_ % 176, n0 = 32 * nb; \
            const float* W = (const float*)(const GAS float*)a.in[which == 0 ? I_F1W1 : which == 1 ? I_F1W3 : which == 2 ? I_F2W1 : I_F2W3]; \
            transpose_item(W, FF, DM, (which < 2) ? W13A : W13B, 64 * kb, n0, (n0 >> 7) * 256 + (n0 & 127) + (which & 1) * 128, scr_, lane, (which < 2) ? nullptr : INP(I_GF2)); break; } \
        r_ -= 4 * CV_I13; \
        if (r_ < 2 * CV_I2) { const int which = r_ / CV_I2; r_ -= which * CV_I2; const int kb = r_ / 64, nb = r_ % 64; \
            transpose_item((const float*)(const GAS float*)a.in[which ? I_F2W2 : I_F1W2], DM, FF, which ? W2B : W2A, 64 * kb, 32 * nb, 32 * nb, scr_, lane); break; } \
        r_ -= 2 * CV_I2; \
        if (r_ < CV_IIN) { const int kb = r_ / 192, nb = r_ % 192; transpose_item(INP(I_WIN), NIN, DM, WINT, 64 * kb, 32 * nb, 32 * nb, scr_, lane, INP(I_GMIX)); break; } \
        r_ -= CV_IIN; \
        { const int kb = r_ / 64, nb = r_ % 64; transpose_item(INP(I_WOUT), DM, DM, WOT, 64 * kb, 32 * nb, 32 * nb, scr_, lane); } } while (0)
#define CONV_QUEUE(cw, lo, hi) do { for (;;) { unsigned q_ = 0; if (lane == 0) q_ = __hip_atomic_fetch_add(ctl + (cw), 4u, RLX_AGENT); \
        const int i0_ = (lo) + (int)__builtin_amdgcn_readfirstlane(q_); if (i0_ >= (hi)) break; \
        for (int k_ = 0; k_ < 4; ++k_) if (i0_ + k_ < (hi)) { CONV_ITEM(i0_ + k_); } } } while (0)
#define PH_PTRS \
    GAS unsigned char* ws_g = (GAS unsigned char*)a.ws; asm volatile("" : "+s"(ws_g)); unsigned char* ws = (unsigned char*)ws_g; \
    GAS float* out_g = (GAS float*)a.out; asm volatile("" : "+s"(out_g)); float* out = (float*)out_g;     \
    unsigned* ctl = (unsigned*)(ws + WS_CTL); (void)ctl; (void)out; \
    bf16* W13A = (bf16*)(ws + WS_W13A); bf16* W13B = (bf16*)(ws + WS_W13B); bf16* W2A = (bf16*)(ws + WS_W2A); bf16* W2B = (bf16*)(ws + WS_W2B); \
    bf16* WINT = (bf16*)(ws + WS_WIN); bf16* WOT = (bf16*)(ws + WS_WO); \
    float* GAINS = (float*)(ws + WS_WF + 512 * 1024); float* WF = (float*)(ws + WS_WF); float* ROPE = (float*)(ws + WS_ROPE); float* CT = (float*)(ws + WS_CT); float* RESID = (float*)(ws + WS_RESID); \
    bf16* XN = (bf16*)(ws + WS_XN); bf16* QA = (bf16*)(ws + WS_QA); bf16* QB = (bf16*)(ws + WS_QB); \
    bf16* KA = (bf16*)(ws + WS_KA); bf16* VA = (bf16*)(ws + WS_VA); bf16* KB = (bf16*)(ws + WS_KB); bf16* VB = (bf16*)(ws + WS_VB); bf16* HB = (bf16*)(ws + WS_H); float* SLABS = (float*)(ws + WS_SLAB); (void)SLABS; \
    bf16* XN2 = (bf16*)(ws + WS_XN2); bf16* HB2 = (bf16*)(ws + WS_H2); float* FGP = (float*)(ws + WS_FGP); float* SSQ1 = (float*)(ws + WS_SSQ1); float* SSQ2 = (float*)(ws + WS_SSQ2); v4u* WFB = (v4u*)(ws + WS_WFB); \
    (void)XN2; (void)HB2; (void)FGP; (void)SSQ1; (void)SSQ2; (void)WFB; \
    (void)W13A; (void)W13B; (void)W2A; (void)W2B; (void)WINT; (void)WOT; (void)GAINS; (void)WF; (void)ROPE; (void)CT; (void)RESID; (void)XN; (void)QA; (void)QB; (void)KA; (void)VA; (void)KB; (void)VB; (void)HB
template <int NMAX> __device__ __forceinline__ void rt_build(const pg8::StaticOrder& S, const float* ssq, LAS float* RT, LAS int* pml, int tid) {
    if (tid < NMAX) { pg8::Unit u; pml[tid] = S.next(tid, u) ? u.pm : -1; }
    __syncthreads();
    const int row = tid & 255, kh = tid >> 8;
    float s[NMAX / 2][8];
#pragma unroll
    for (int j = 0; j < NMAX / 2; ++j) { const int pm = pml[2 * j + kh]; const GAS float* p = (const GAS float*)ssq + (size_t)(pm < 0 ? 0 : pm) * 256 + row;
#pragma unroll
        for (int q = 0; q < 8; ++q) s[j][q] = p[(size_t)q * M1]; }
#pragma unroll
    for (int j = 0; j < NMAX / 2; ++j) RT[(2 * j + kh) * 256 + row] = __builtin_amdgcn_rsqf((((s[j][0] + s[j][1]) + (s[j][2] + s[j][3])) + ((s[j][4] + s[j][5]) + (s[j][6] + s[j][7]))) * (1.0f / 2048.0f) + 1e-6f);
    __syncthreads();
}
__device__ __forceinline__ int opq(int k) { asm volatile("" : "+s"(k)); return k; }
#define INP(k) ((const float*)(const GAS float*)a.in[opq(k)])
__global__ void __launch_bounds__(512, 2) fwd(Args a) {
    extern __shared__ __attribute__((aligned(16))) unsigned char lds_raw[];
    LAS unsigned char* lds = (LAS unsigned char*)lds_raw;
    const int tid = threadIdx.x, lane = tid & 63, wid = __builtin_amdgcn_readfirstlane(tid >> 6);
    const int G = gridDim.x, bx = blockIdx.x;
    const int gw = bx * 8 + wid, NGW = G * 8;
    unsigned* ctl0 = (unsigned*)(a.ws + WS_CTL);
    for (int u = tid; u < (LDS_BYTES - LDS_CTL) / 4; u += 512) ((LAS unsigned*)(lds + LDS_CTL))[u] = 0u;
    __syncthreads();
    const int lo = a.ph_lo, hi = a.ph_hi;
    XcdBarrier bar; bar.bar = ctl0 + CW_BAR + a.li * XCD_BAR_WORDS; bar.x = 0; bar.st = nullptr;
    if (hi - lo > 1) bar = xcd_barrier_post(ctl0 + CW_BAR + a.li * XCD_BAR_WORDS, (volatile LAS unsigned*)(lds + LDS_CTL));
#ifndef MK_SPLITK
#define MK_SPLITK 0
#endif
#ifndef MK_ATT_A
#define MK_ATT_A 1
#endif
#ifndef MK_ATT_B
#define MK_ATT_B 1
#endif
#ifndef MK_PHASE_MASK
#define MK_PHASE_MASK 0x7ff
#endif
#define IN(k) ((((MK_PHASE_MASK) >> (k)) & 1) && lo <= (k) && (k) < hi)
#define SEAM(k) do { if (IN(k) && IN((k) + 1)) xcd_barrier(bar); } while (0)

    if (IN(0)) {
        PH_PTRS;
#ifndef MK_P0_REP
#define MK_P0_REP 1
#endif
        for (int rep0 = 0; rep0 < MK_P0_REP; ++rep0) {
        LAS float* scr = (LAS float*)(lds + LDS_RING + wid * 16384);
        for (int it = gw; it < 2 * CV_I13; it += NGW) { CONV_ITEM(it); }
        for (int i = bx * 512 + tid; i < 512; i += G * 512) GAINS[i] = a.in[I_GQA + (i >> 7)][i & 127];
        for (int i = bx * 512 + tid; i < 64 * 64; i += G * 512) {
            const int blk = i >> 6, c = i & 15, g4 = (i >> 4) & 3; float w[8];
#pragma unroll
            for (int j = 0; j < 8; ++j) { const int k = 32 * blk + (j < 4 ? 4 * g4 + j : 12 + 4 * g4 + j); w[j] = (c < 8) ? INP(I_WIN)[(size_t)k * NIN + NQKV + c] * INP(I_GMIX)[k] : 0.f; }
            v4u o; o.x = pk2(w[0], w[1]); o.y = pk2(w[2], w[3]); o.z = pk2(w[4], w[5]); o.w = pk2(w[6], w[7]); *(GAS v4u*)(WFB + i) = o;
        }
        if (bx == 0 && wid == 0) {
            const float* q1 = INP(I_LQ1); const float* k1 = INP(I_LK1); const float* q2 = INP(I_LQ2); const float* k2 = INP(I_LK2);
            const float s1 = wave_sum(q1[lane] * k1[lane] + q1[lane + 64] * k1[lane + 64]), s2 = wave_sum(q2[lane] * k2[lane] + q2[lane + 64] * k2[lane + 64]);
            if (lane == 0) ((float*)ctl)[CW_LAM] = expf(s1) - expf(s2) + 0.2f;
            float gq = fmaxf(fabsf(INP(I_GQB)[lane]), fabsf(INP(I_GQB)[lane + 64])), gk = fmaxf(fabsf(INP(I_GKB)[lane]), fabsf(INP(I_GKB)[lane + 64]));
#pragma unroll
            for (int o = 1; o < 64; o <<= 1) { gq = fmaxf(gq, __shfl_xor(gq, o)); gk = fmaxf(gk, __shfl_xor(gk, o)); }
            if (lane == 0) ((float*)ctl)[CW_PRUNE] = 2.0f * 16.5f * gq * gk + 40.0f;
        }
        const float* xp_ = INP(I_XP); const float* xs_ = INP(I_XS); const float* mt_ = INP(I_META);
        for (int R = gw; R < M1; R += NGW) {
            const float* xr = (R < 32768) ? xp_ + (size_t)R * DM : (R < 34816) ? xs_ + (size_t)(R - 32768) * DM : (R < 34832) ? mt_ + (size_t)(R - 34816) * DM : nullptr; f32x4 v[8];
            if (xr) { const float rs = rms_load(xr, lane, v); const GAS f32x4* g = (const GAS f32x4*)INP(I_GF1) + lane;
#pragma unroll
                for (int j = 0; j < 8; ++j) v[j] = v[j] * rs * g[64 * j]; }
            else {
#pragma unroll
                for (int j = 0; j < 8; ++j) v[j] = (f32x4){0.f, 0.f, 0.f, 0.f}; }
            store_row_bf16(XN + (size_t)R * DM, lane, v);
        }
        }
    }
    SEAM(0);
    if (IN(1)) {
        PH_PTRS;
#ifndef MK_P1_REP
#define MK_P1_REP 1
#endif
        for (int rep = 0; rep < MK_P1_REP; ++rep) {
        pg8::Gemm g{XN, W13A, M1, 2 * FF, DM, DM}; pg8::StaticOrder S; S.init(M1, 2 * FF, G, bx);
        pg8::EpiSwiGLU<false> E{HB, nullptr, FF};
        pg8::gemm_phase<pg8::EpiSwiGLU<false>, pg8::StaticOrder, true, true>(lds + LDS_RING, g, S, E);
        }
        CONV_QUEUE(CW_CQ0, 4 * CV_I13, 4 * CV_I13 + CV_I2);
    }
    SEAM(1);
    if (IN(2)) {
        PH_PTRS;
        pg8::Gemm g{HB, W2A, M1, DM, FF, FF}; pg8::StaticOrder S; S.init(M1, DM, G, bx); if (MK_SPLITK) S.nr = S.nwg / G;
        pg8::EpiResidN<1, true> E{RESID, INP(I_XP), INP(I_XS), INP(I_META), XN, SSQ1, FGP, (const pg8::u32x4*)WFB, (PG8_LAS float*)(lds + LDS_SCR), M1, 0.5f};
        pg8::gemm_phase<pg8::EpiResidN<1, true>, pg8::StaticOrder, true, true>(lds + LDS_RING, g, S, E);
        pg8::Gemm g4{HB, W2A, M1, DM, FF / 4, FF}; pg8::TailOrder T; T.init(M1, DM, G, bx, 4, FF / 4);
        pg8::EpiSlab EA{SLABS};
        if (MK_SPLITK) pg8::gemm_phase<pg8::EpiSlab, pg8::TailOrder, true, true>(lds + LDS_RING, g4, T, EA);
        CONV_QUEUE(CW_CQ1, 2 * CV_I13, 4 * CV_I13);
        CONV_QUEUE(CW_CQ2, 4 * CV_I13 + CV_I2, CV_N);
    }
    SEAM(2);
    if (IN(3)) {
        PH_PTRS;
        static_assert(!MK_SPLITK, "the folded norms take whole tiles from the residual epilogues");
        for (int it = bx * 512 + tid; it < 34832 * 8; it += G * 512) {
            const int R = it >> 3, h = it & 7;
            const GAS float* sp = (const GAS float*)SSQ1 + R; const GAS float* fp = (const GAS float*)FGP + (size_t)R * 8 + h;
            float sq[8], fz[32];
#pragma unroll
            for (int q = 0; q < 8; ++q) sq[q] = sp[(size_t)q * M1];
#pragma unroll
            for (int q = 0; q < 32; ++q) fz[q] = fp[(size_t)q * M1 * 8];
            float zs = 0.f;
#pragma unroll
            for (int q = 0; q < 32; ++q) zs += fz[q];
            const float rs = __builtin_amdgcn_rsqf((((sq[0] + sq[1]) + (sq[2] + sq[3])) + ((sq[4] + sq[5]) + (sq[6] + sq[7]))) * (1.0f / 2048.0f) + 1e-6f);
            const float z = zs * rs + a.in[I_BF][h];
            const float lf = fminf(z, 0.f) - log1pf(expf(-fabsf(z)));
            if (R < 32768) out[O_LFP + ((size_t)((R >> 13) * SEQP + 16 + (R & 8191))) * 8 + h] = lf;
            else if (R < 34816) out[O_LFS + (size_t)(R - 32768) * 8 + h] = lf;
            else { for (int b = 0; b < 4; ++b) out[O_LFP + ((size_t)(b * SEQP + (R - 34816))) * 8 + h] = lf; }
        }
        {
            for (int i = bx * 512 + tid; i < 4 * 4 * 48 * 128; i += G * 512) {
                const int c8 = i & 127, row = (i >> 7) % 48, bt = (i >> 7) / 48, b = bt & 3, t = bt >> 2;
                bf16* dst = (t == 0 ? KA : t == 1 ? VA : t == 2 ? KB : VB) + ((size_t)(b * PSTR + 16 + row) * 1024 + c8 * 8);
                *(GAS v4u*)dst = (v4u){0u, 0u, 0u, 0u};
            }
        }
    }
    SEAM(3);
    if (IN(4)) {
        PH_PTRS;
        if (G - 1 - bx < 36 && G >= 36) {
            const int s = G - 1 - bx, head = tid & 7, seg = tid >> 3;
            const bool pr = s < 4; const int L = pr ? SEQP : SSTR, sl = pr ? 129 : 33;
            const int i0 = seg * sl, i1 = (i0 + sl < L) ? i0 + sl : L;
            const float* lfp = pr ? out + O_LFP + (size_t)s * SEQP * 8 : nullptr;
            const float* lfc = pr ? nullptr : INP(I_CLF) + (size_t)(s - 4) * 2048 * 8; const float* lfn = pr ? nullptr : out + O_LFS + (size_t)(s - 4) * 64 * 8;
#define LF_AT(i) (pr ? lfp[(size_t)(i) * 8 + head] : ((i) < 2048 ? lfc[(size_t)(i) * 8 + head] : lfn[(size_t)((i) - 2048) * 8 + head]))
            float acc = 0.f;
            for (int k = i0; k < i1; k += 16) { float v[16];
#pragma unroll
                for (int u = 0; u < 16; ++u) v[u] = (k + u < i1) ? LF_AT(k + u) : 0.f;
#pragma unroll
                for (int u = 0; u < 16; ++u) acc += v[u]; }
            LAS float* ps = (LAS float*)(lds + LDS_RING);
            ps[seg * 8 + head] = acc;
            __syncthreads();
            float run = 0.f;
            for (int q = 0; q < seg; ++q) run += ps[q * 8 + head];
            float* cth = CT + (size_t)head * NSR + (pr ? (size_t)s * PSTR : (size_t)SROW_S0 + (size_t)(s - 4) * SSTR);
            for (int k = i0; k < i1; k += 16) { float v[16];
#pragma unroll
                for (int u = 0; u < 16; ++u) v[u] = (k + u < i1) ? LF_AT(k + u) : 0.f;
#pragma unroll
                for (int u = 0; u < 16; ++u) { run += v[u]; const int i = k + u; if (i < i1) cth[pr ? (i < 16 ? i : 48 + i) : i] = run * 1.4426950408889634f; } }
#undef LF_AT
            if (pr && tid < 48 * 8) CT[(size_t)(tid & 7) * NSR + (size_t)s * PSTR + 16 + (tid >> 3)] = 0.f;
            __syncthreads();
        }
        pg8::Gemm g{XN, WINT, M1, NQKV, DM, DM}; pg8::StaticOrder S; S.init(M1, NQKV, G, bx);
        for (int i = tid; i < 512; i += 512) ((LAS float*)(lds + LDS_SCR + 8192))[i] = GAINS[i];
        __syncthreads();
        rt_build<14>(S, SSQ1, (LAS float*)(lds + LDS_RT), (LAS int*)(lds + LDS_RING), tid);
        pg8::EpiQKV E{out, QA, KA, (const PG8_LAS float*)(lds + LDS_SCR + 8192), (PG8_LAS float*)(lds + LDS_SCR), (const PG8_LAS float*)(lds + LDS_RT), (size_t)(WS_QB - WS_QA) / 2, SBUF / 2, O_AKP, O_AVP - O_AKP, O_AKS, O_AVS - O_AKS};
#ifndef MK_P4_REP
#define MK_P4_REP 1
#endif
        for (int rep4 = 0; rep4 < MK_P4_REP; ++rep4)
        pg8::gemm_phase<pg8::EpiQKV, pg8::StaticOrder, true, true>(lds + LDS_RING, g, S, E);
    }
    SEAM(4);
    if (IN(5)) {
        PH_PTRS;
        const float lam = ((const float*)ctl)[CW_LAM], prune_thr = ((const float*)ctl)[CW_PRUNE];
#ifndef MK_ATT_REP
#define MK_ATT_REP 1
#endif
        const int myq = (int)(xb_xcc_id() & 7u); int qsel = 0;
        for (;;) {
            if (tid == 0) {
                unsigned w = 0x7fffffffu; int qq = myq;
                for (; qsel < 8; ++qsel) { qq = (myq + qsel) & 7; w = __hip_atomic_fetch_add(ctl + CW_QUEUE + 64 * qq, 1u, RLX_AGENT); if (w < (unsigned)att::N_Q_UNITS) break; }
                *(volatile LAS unsigned*)(lds + att::A_QW) = (qsel < 8) ? w : 0x7fffffffu; *(volatile LAS unsigned*)(lds + att::A_QW + 4) = (unsigned)qq;
            }
            asm volatile("s_waitcnt vmcnt(0) lgkmcnt(0)" ::: "memory"); __builtin_amdgcn_s_barrier(); asm volatile("" ::: "memory");
            const int w = __builtin_amdgcn_readfirstlane(*(volatile LAS unsigned*)(lds + att::A_QW)), qq = __builtin_amdgcn_readfirstlane(*(volatile LAS unsigned*)(lds + att::A_QW + 4));
            att::UnitP U;
            if (w >= att::N_Q_UNITS || !att::decode_unit(qq, w, U)) break;
            if (MK_ATT_A && (U.kind == 0 || U.kind == 2)) att::attn_unit_a16(lds, U, QA, KA, VA, INP(I_GOA), lam, XN, INP(I_CAK), INP(I_CAV), wid, lane);
            else if (MK_ATT_B) att::attn_unit<128, true>(lds, U, QB, KB, VB, CT, INP(I_GOB), lam, prune_thr, XN, INP(I_CBK), INP(I_CBV), wid, lane);
        }
    }
    SEAM(5);
    if (IN(6)) {
        PH_PTRS;
        pg8::Gemm g{XN, WOT, MA, DM, DM, DM}; pg8::StaticOrder S; S.init(MA, DM, G, bx); if (MK_SPLITK) S.nr = S.nwg / G;
        pg8::EpiResidN<0, false> E{RESID, nullptr, nullptr, nullptr, XN2, SSQ2, nullptr, nullptr, (PG8_LAS float*)(lds + LDS_SCR), M1, 1.0f};
        pg8::gemm_phase<pg8::EpiResidN<0, false>, pg8::StaticOrder, true, true>(lds + LDS_RING, g, S, E);
        pg8::Gemm g4{XN, WOT, MA, DM, DM / 4, DM}; pg8::TailOrder T; T.init(MA, DM, G, bx, 4, DM / 4);
        pg8::EpiSlab EA{SLABS};
        if (MK_SPLITK) pg8::gemm_phase<pg8::EpiSlab, pg8::TailOrder, true, true>(lds + LDS_RING, g4, T, EA);
    }
    SEAM(6);
    if (IN(8)) {
        PH_PTRS;
        pg8::Gemm g{XN2, W13B, MA, 2 * FF, DM, DM}; pg8::StaticOrder S; S.init(MA, 2 * FF, G, bx);
        rt_build<24>(S, SSQ2, (LAS float*)(lds + LDS_SCR), (LAS int*)(lds + LDS_RING), tid);
        pg8::EpiSwiGLU<true> E{HB2, (const PG8_LAS float*)(lds + LDS_SCR), FF};
        pg8::gemm_phase<pg8::EpiSwiGLU<true>, pg8::StaticOrder, true, true>(lds + LDS_RING, g, S, E);
    }
    SEAM(8);
    if (IN(9)) {
        PH_PTRS;
        pg8::Gemm g{HB2, W2B, MA, DM, FF, FF}; pg8::StaticOrder S; S.init(MA, DM, G, bx); if (MK_SPLITK) S.nr = S.nwg / G;
        pg8::EpiResid<0> E{RESID, nullptr, nullptr, nullptr, 0.5f};
        pg8::gemm_phase<pg8::EpiResid<0>, pg8::StaticOrder, true, true>(lds + LDS_RING, g, S, E);
        pg8::Gemm g4{HB2, W2B, MA, DM, FF / 4, FF}; pg8::TailOrder T; T.init(MA, DM, G, bx, 4, FF / 4);
        pg8::EpiSlab EA{SLABS};
        if (MK_SPLITK) pg8::gemm_phase<pg8::EpiSlab, pg8::TailOrder, true, true>(lds + LDS_RING, g4, T, EA);
    }
    SEAM(9);
    if (IN(10)) {
        PH_PTRS;
#ifndef MK_P10_REP
#define MK_P10_REP 1
#endif
        LAS unsigned short* ttab = (LAS unsigned short*)(lds + LDS_SCR);
        if (MK_SPLITK) build_tail_table(ttab, MA, G, tid);
        for (int R = gw; R < MA; R += 2 * NGW) {
            const int R2 = R + NGW; const bool has2 = R2 < MA;
            f32x4 v[8], w[8]; row_load(RESID + (size_t)R * DM, lane, v); if (has2) row_load(RESID + (size_t)R2 * DM, lane, w);
            const GAS f32x4* g = (const GAS f32x4*)INP(I_GFIN) + lane;
            const float rs = row_rstd(v);
            GAS f32x4* o = (GAS f32x4*)(out + O_YP + (size_t)R * DM) + lane;
#pragma unroll
            for (int j = 0; j < 8; ++j) o[64 * j] = v[j] * rs * g[64 * j];
            if (has2) { const float rs2 = row_rstd(w); GAS f32x4* o2 = (GAS f32x4*)(out + O_YP + (size_t)R2 * DM) + lane;
#pragma unroll
                for (int j = 0; j < 8; ++j) o2[64 * j] = w[j] * rs2 * g[64 * j]; }
        }
    }
#undef IN
#undef SEAM
}

extern "C" void kernel_launch(void* const* d_in, const int* in_sizes, int n_in, void* d_out, int out_size, void* d_ws, size_t ws_size, hipStream_t stream) {
    static int grid = 0;
    if (grid == 0) {
        if (n_in != 31 || (size_t)out_size != O_END || ws_size < WS_END) { fprintf(stderr, "kernel_launch: shape mismatch: n_in %d out %d ws %zu (need %zu)\n", n_in, out_size, ws_size, (size_t)WS_END); grid = -1; return; }
        int dev = 0, cus = 0, per_cu = 0;
        if (hipGetDevice(&dev) != hipSuccess || hipDeviceGetAttribute(&cus, hipDeviceAttributeMultiprocessorCount, dev) != hipSuccess) { grid = -1; return; }
        if (hipFuncSetAttribute((const void*)fwd, hipFuncAttributeMaxDynamicSharedMemorySize, LDS_BYTES) != hipSuccess) { fprintf(stderr, "kernel_launch: hipFuncSetAttribute failed\n"); grid = -1; return; }
        if (hipOccupancyMaxActiveBlocksPerMultiprocessor(&per_cu, (const void*)fwd, 512, LDS_BYTES) != hipSuccess || per_cu < 1) { fprintf(stderr, "kernel_launch: occupancy query says %d\n", per_cu); }
        (void)hipGetLastError();
        grid = cus;
        if ((137 * 24 + grid - 1) / grid > 14 || (136 * 44 + grid - 1) / grid > 24) { fprintf(stderr, "kernel_launch: %d CUs: row-scale tables too small\n", grid); grid = -1; return; }
    }
    if (grid < 0) return;
    if (hipMemsetAsync((char*)d_ws + WS_CTL, 0, CTL_ZERO_BYTES, stream) != hipSuccess) return;
    Args a{};
    for (int i = 0; i < 31; ++i) a.in[i] = (const float*)d_in[i];
    a.out = (float*)d_out; a.ws = (unsigned char*)d_ws;
#if MK_PER_PHASE
    for (int p = 0; p < N_PHASES; ++p) { a.ph_lo = p; a.ph_hi = p + 1; hipLaunchKernelGGL(fwd, dim3(grid), dim3(512), LDS_BYTES, stream, a); }
#else
#ifdef MK_PROBE_SPLIT
    a.ph_lo = 0; a.ph_hi = MK_PROBE_SPLIT + 1; a.li = 0;
    hipLaunchKernelGGL(fwd, dim3(grid), dim3(512), LDS_BYTES, stream, a);
    a.ph_lo = MK_PROBE_SPLIT; a.ph_hi = N_PHASES; a.li = 1;
    hipLaunchKernelGGL(fwd, dim3(grid), dim3(512), LDS_BYTES, stream, a);
#else
    a.ph_lo = 0; a.ph_hi = N_PHASES;
    hipLaunchKernelGGL(fwd, dim3(grid), dim3(512), LDS_BYTES, stream, a);
#endif
#endif
    const hipError_t le = hipPeekAtLastError();
    if (le != hipSuccess) fprintf(stderr, "kernel_launch: launch failed: %s\n", hipGetErrorName(le));
}
```
